# Optimizing an MI355X kernel written in HIP

```python
import math
import jax, jax.numpy as jnp
from jax import lax
import numpy as np

D_MODEL = 1024
BATCH = 8
SEQ = 2048
DEPTH = 4

MEM_LEN = 256
ROPE_THETA = 10000.0
EPS = 1e-6
Q_BLOCK = 128
D_FF = 2816
MLA_HEADS = 8
MLA_NOPE = 64
MLA_ROPE = 32
MLA_V = 64
MLA_Q_LORA = 256
MLA_KV_LORA = 128
DIL_PATTERNS = ((128, 1), (512, 4), (2048, 16))
DIL_GROUPS = len(DIL_PATTERNS)
DIL_HEADS = 4
DIL_HD = 64
SPA_HEADS = 16
SPA_HD = 64
IDX_HEADS = 8
IDX_HD = 64
TOPK_MAX = 256
X_HEADS = 4
X_HD = D_MODEL // X_HEADS
FULL_ROPE_DIM = 64

EVEN_IN = MLA_Q_LORA + MLA_KV_LORA + MLA_ROPE + 3 * DIL_GROUPS * DIL_HEADS * DIL_HD
EVEN_MIX = MLA_HEADS * MLA_V + DIL_HEADS * DIL_HD
ODD_IN = SPA_HEADS * SPA_HD + 2 * SPA_HD + IDX_HEADS * IDX_HD + IDX_HD + IDX_HEADS
ODD_MIX = SPA_HEADS * SPA_HD
N_EVEN = (DEPTH + 1) // 2
N_ODD = DEPTH // 2

kernel_name = 'hybrid_mla_dilated_dsa_macaron'


def rms_norm(x, g):
    xf = x.astype(jnp.float32)
    y = xf * lax.rsqrt(jnp.mean(xf * xf, axis=-1, keepdims=True) + EPS)
    return (y * g.astype(jnp.float32)).astype(x.dtype)


def rope_tables(positions, dim):
    inv = jnp.exp(-math.log(ROPE_THETA) * jnp.arange(0, dim, 2, dtype=jnp.float32) / dim)
    ang = positions.astype(jnp.float32)[..., None] * inv
    return jnp.cos(ang), jnp.sin(ang)


def apply_rope(x, cos, sin):
    half = x.shape[-1] // 2
    xf = x.astype(jnp.float32)
    x1, x2 = xf[..., :half], xf[..., half:]
    return jnp.concatenate([x1 * cos - x2 * sin, x2 * cos + x1 * sin], axis=-1).astype(x.dtype)


def swiglu(h, w13, w2):
    gu = h @ w13
    g, u = jnp.split(gu, 2, axis=-1)
    return (jax.nn.silu(g) * u) @ w2


def causal_block_attention(q, k, v, scale):
    B, S, H, _ = q.shape
    nb = S // Q_BLOCK
    qb = q.reshape(B, nb, Q_BLOCK, H, q.shape[-1]).swapaxes(0, 1)
    kpos = jnp.arange(S)

    def blk(args):
        qi, i = args
        qpos = i * Q_BLOCK + jnp.arange(Q_BLOCK)
        s = jnp.einsum('bqhd,bkhd->bhqk', qi, k).astype(jnp.float32) * scale
        s = jnp.where(kpos[None, :] <= qpos[:, None], s, -jnp.inf)
        p = jax.nn.softmax(s, axis=-1).astype(v.dtype)
        return jnp.einsum('bhqk,bkhd->bqhd', p, v)

    out = lax.map(blk, (qb, jnp.arange(nb)))
    return out.swapaxes(0, 1).reshape(B, S, H, v.shape[-1])


def dilated_group_attention(q, k, v, dilation, w_sub):
    B, S, H, E = q.shape
    L = S // dilation
    blk = w_sub
    nb = -(-L // blk)
    Lp = nb * blk

    def to_sub(a):
        a = a.reshape(B, L, dilation, H, E).transpose(0, 2, 1, 3, 4)
        return jnp.pad(a, ((0, 0), (0, 0), (0, Lp - L), (0, 0), (0, 0)))

    def windows(a):
        a = jnp.pad(a, ((0, 0), (0, 0), (blk, 0), (0, 0), (0, 0))).reshape(B, dilation, nb + 1, blk, H, E)
        return jnp.concatenate([a[:, :, :-1], a[:, :, 1:]], axis=3)

    qb = to_sub(q).reshape(B, dilation, nb, blk, H, E)
    kw = windows(to_sub(k))
    vw = windows(to_sub(v))
    s = jnp.einsum('bdnqhe,bdnkhe->bdnhqk', qb, kw).astype(jnp.float32) * (E ** -0.5)
    qi = jnp.arange(blk)[:, None]
    ki = jnp.arange(2 * blk)[None, :]
    rel = blk + qi - ki
    band = (rel >= 0) & (rel <= w_sub)
    kstart = (jnp.arange(nb)[:, None] - 1) * blk + jnp.arange(2 * blk)[None, :]
    mask = band[None] & (kstart >= 0)[:, None, :]
    s = jnp.where(mask[None, None, :, None], s, -jnp.inf)
    lse = jax.nn.logsumexp(s, axis=-1)
    p = jnp.exp(s - lse[..., None]).astype(v.dtype)
    o = jnp.einsum('bdnhqk,bdnkhe->bdnqhe', p, vw).reshape(B, dilation, Lp, H, E)[:, :, :L]
    o = o.transpose(0, 2, 1, 3, 4).reshape(B, S, H, E)
    lse = lse.transpose(0, 1, 2, 4, 3).reshape(B, dilation, Lp, H)[:, :, :L]
    lse = lse.transpose(0, 2, 1, 3).reshape(B, S, H)
    return o, lse


def even_mixer(h, w_in, q_lora_g, kv_lora_g, w_uq, w_ukv, mla_q_g, mla_k_g, dil_q_g, dil_k_g, w_out,
               cos32, sin32, cos64, sin64):
    B, S, _ = h.shape
    cols = h @ w_in
    o1 = MLA_Q_LORA
    o2 = o1 + MLA_KV_LORA
    o3 = o2 + MLA_ROPE
    c_q = rms_norm(cols[..., :o1], q_lora_g)
    c_kv = rms_norm(cols[..., o1:o2], kv_lora_g)
    q = (c_q @ w_uq).reshape(B, S, MLA_HEADS, MLA_NOPE + MLA_ROPE)
    q_nope = rms_norm(q[..., :MLA_NOPE], mla_q_g[:MLA_NOPE])
    q_rope = apply_rope(rms_norm(q[..., MLA_NOPE:], mla_q_g[MLA_NOPE:]), cos32[:, :, None], sin32[:, :, None])
    kv = (c_kv @ w_ukv).reshape(B, S, MLA_HEADS, MLA_NOPE + MLA_V)
    k_nope = rms_norm(kv[..., :MLA_NOPE], mla_k_g[:MLA_NOPE])
    v_a = kv[..., MLA_NOPE:]
    k_rope = apply_rope(rms_norm(cols[..., o2:o3], mla_k_g[MLA_NOPE:]), cos32, sin32)
    q_a = jnp.concatenate([q_nope, q_rope], axis=-1)
    k_a = jnp.concatenate([k_nope, jnp.broadcast_to(k_rope[:, :, None], (B, S, MLA_HEADS, MLA_ROPE))], axis=-1)
    mla_out = causal_block_attention(q_a, k_a, v_a, (MLA_NOPE + MLA_ROPE) ** -0.5)
    mla_out = mla_out.reshape(B, S, MLA_HEADS * MLA_V)
    dil = cols[..., o3:].reshape(B, S, DIL_GROUPS, 3, DIL_HEADS, DIL_HD)
    dq = apply_rope(rms_norm(dil[:, :, :, 0], dil_q_g), cos64[:, :, None, None], sin64[:, :, None, None])
    dk = apply_rope(rms_norm(dil[:, :, :, 1], dil_k_g), cos64[:, :, None, None], sin64[:, :, None, None])
    dv = dil[:, :, :, 2]
    outs, lses = [], []
    for g, (window, dilation) in enumerate(DIL_PATTERNS):
        o_g, lse_g = dilated_group_attention(dq[:, :, g], dk[:, :, g], dv[:, :, g], dilation, window // dilation)
        outs.append(o_g)
        lses.append(lse_g)
    wts = jax.nn.softmax(jnp.stack(lses, axis=0), axis=0)
    dil_out = jnp.sum(wts[..., None] * jnp.stack(outs, axis=0).astype(jnp.float32), axis=0).astype(h.dtype)
    dil_out = dil_out.reshape(B, S, DIL_HEADS * DIL_HD)
    return jnp.concatenate([mla_out, dil_out], axis=-1) @ w_out


def sparse_mixer(h, w_in, q_g, k_g, w_out, cos64, sin64):
    B, S, _ = h.shape
    cols = h @ w_in
    o1 = SPA_HEADS * SPA_HD
    o2 = o1 + SPA_HD
    o3 = o2 + SPA_HD
    o4 = o3 + IDX_HEADS * IDX_HD
    o5 = o4 + IDX_HD
    q = apply_rope(rms_norm(cols[..., :o1].reshape(B, S, SPA_HEADS, SPA_HD), q_g), cos64[:, :, None], sin64[:, :, None])
    k = apply_rope(rms_norm(cols[..., o1:o2], k_g), cos64, sin64)
    v = cols[..., o2:o3]
    qi = apply_rope(cols[..., o3:o4].reshape(B, S, IDX_HEADS, IDX_HD), cos64[:, :, None], sin64[:, :, None])
    ki = apply_rope(cols[..., o4:o5], cos64, sin64)
    wi = cols[..., o5:] * (IDX_HEADS ** -0.5)
    n_keep = min(TOPK_MAX, S // 4)
    nb = S // Q_BLOCK
    kpos = jnp.arange(S)

    def to_blocks(a):
        return a.reshape((B, nb, Q_BLOCK) + a.shape[2:]).swapaxes(0, 1)

    def attend(args):
        qb, qib, wib, i = args
        qpos = i * Q_BLOCK + jnp.arange(Q_BLOCK)
        logits = jnp.einsum('bqhe,bse->bqhs', qib, ki).astype(jnp.float32) * (IDX_HD ** -0.5)
        score = jnp.einsum('bqh,bqhs->bqs', wib.astype(jnp.float32), jax.nn.relu(logits))
        score = jnp.where(kpos[None, None, :] <= qpos[None, :, None], score, -jnp.inf)
        _, idx = lax.top_k(score, n_keep)
        valid = idx <= qpos[None, :, None]
        kg = jax.vmap(lambda a, ix: a[ix])(k, idx)
        vg = jax.vmap(lambda a, ix: a[ix])(v, idx)
        s = jnp.einsum('bqhe,bqke->bqhk', qb, kg).astype(jnp.float32) * (SPA_HD ** -0.5)
        s = jnp.where(valid[:, :, None, :], s, -jnp.inf)
        p = jax.nn.softmax(s, axis=-1).astype(vg.dtype)
        return jnp.einsum('bqhk,bqke->bqhe', p, vg)

    out = lax.map(attend, (to_blocks(q), to_blocks(qi), to_blocks(wi), jnp.arange(nb)))
    out = out.swapaxes(0, 1).reshape(B, S, ODD_MIX)
    return out @ w_out


def memory_cross_attention(h, mem_n, wq, wkv, q_g, k_g, wo):
    B, S, _ = h.shape
    M = mem_n.shape[1]
    q = rms_norm((h @ wq).reshape(B, S, X_HEADS, X_HD), q_g)
    kv = (mem_n @ wkv).reshape(B, M, 2, X_HEADS, X_HD)
    k = rms_norm(kv[:, :, 0], k_g)
    v = kv[:, :, 1]
    s = jnp.einsum('bshd,bmhd->bhsm', q, k).astype(jnp.float32) * (X_HD ** -0.5)
    p = jax.nn.softmax(s, axis=-1).astype(v.dtype)
    o = jnp.einsum('bhsm,bmhd->bshd', p, v).reshape(B, S, D_MODEL)
    return o @ wo


def setup_inputs(seed: int = 0) -> dict:
    key = jax.random.key(seed)
    ks = iter(jax.random.split(key, 40))

    def w(shape, fan_in):
        return jax.random.normal(next(ks), shape, jnp.float32) * (fan_in ** -0.5)

    def gain(shape):
        return 1.0 + 0.02 * jax.random.normal(next(ks), shape, jnp.float32)

    x = jax.random.normal(next(ks), (BATCH, SEQ, D_MODEL), jnp.float32)
    mem = jax.random.normal(next(ks), (BATCH, MEM_LEN, D_MODEL), jnp.float32)
    offsets = jax.random.randint(next(ks), (BATCH, 1), 0, 4096, dtype=jnp.int32)
    positions = (offsets + jnp.arange(SEQ, dtype=jnp.int32)[None, :]).astype(jnp.int32)
    return {
        'x': x, 'mem': mem, 'positions': positions,
        'ffn1_norm': gain((DEPTH, D_MODEL)),
        'ffn1_w13': w((DEPTH, D_MODEL, 2 * D_FF), D_MODEL),
        'ffn1_w2': w((DEPTH, D_FF, D_MODEL), D_FF),
        'mix_norm': gain((DEPTH, D_MODEL)),
        'xattn_norm': gain((DEPTH, D_MODEL)),
        'mem_norm': gain((DEPTH, D_MODEL)),
        'xattn_wq': w((DEPTH, D_MODEL, D_MODEL), D_MODEL),
        'xattn_wkv': w((DEPTH, D_MODEL, 2 * D_MODEL), D_MODEL),
        'xattn_q_gain': gain((DEPTH, X_HD)),
        'xattn_k_gain': gain((DEPTH, X_HD)),
        'xattn_wo': w((DEPTH, D_MODEL, D_MODEL), D_MODEL),
        'ffn2_norm': gain((DEPTH, D_MODEL)),
        'ffn2_w13': w((DEPTH, D_MODEL, 2 * D_FF), D_MODEL),
        'ffn2_w2': w((DEPTH, D_FF, D_MODEL), D_FF),
        'even_w_in': w((N_EVEN, D_MODEL, EVEN_IN), D_MODEL),
        'mla_q_lora_norm': gain((N_EVEN, MLA_Q_LORA)),
        'mla_kv_lora_norm': gain((N_EVEN, MLA_KV_LORA)),
        'mla_w_uq': w((N_EVEN, MLA_Q_LORA, MLA_HEADS * (MLA_NOPE + MLA_ROPE)), MLA_Q_LORA),
        'mla_w_ukv': w((N_EVEN, MLA_KV_LORA, MLA_HEADS * (MLA_NOPE + MLA_V)), MLA_KV_LORA),
        'mla_q_gain': gain((N_EVEN, MLA_NOPE + MLA_ROPE)),
        'mla_k_gain': gain((N_EVEN, MLA_NOPE + MLA_ROPE)),
        'dil_q_gain': gain((N_EVEN, DIL_HD)),
        'dil_k_gain': gain((N_EVEN, DIL_HD)),
        'even_w_out': w((N_EVEN, EVEN_MIX, D_MODEL), EVEN_MIX),
        'odd_w_in': w((N_ODD, D_MODEL, ODD_IN), D_MODEL),
        'sparse_q_gain': gain((N_ODD, SPA_HD)),
        'sparse_k_gain': gain((N_ODD, SPA_HD)),
        'odd_w_out': w((N_ODD, ODD_MIX, D_MODEL), ODD_MIX),
    }


def reference(x, mem, positions, ffn1_norm, ffn1_w13, ffn1_w2, mix_norm, xattn_norm, mem_norm,
              xattn_wq, xattn_wkv, xattn_q_gain, xattn_k_gain, xattn_wo, ffn2_norm, ffn2_w13, ffn2_w2,
              even_w_in, mla_q_lora_norm, mla_kv_lora_norm, mla_w_uq, mla_w_ukv, mla_q_gain, mla_k_gain,
              dil_q_gain, dil_k_gain, even_w_out, odd_w_in, sparse_q_gain, sparse_k_gain, odd_w_out):
    cos32, sin32 = rope_tables(positions, MLA_ROPE)
    cos64, sin64 = rope_tables(positions, FULL_ROPE_DIM)
    for i in range(DEPTH):
        j = i // 2
        x = x + 0.5 * swiglu(rms_norm(x, ffn1_norm[i]), ffn1_w13[i], ffn1_w2[i])
        h = rms_norm(x, mix_norm[i])
        if i % 2 == 0:
            mix = even_mixer(h, even_w_in[j], mla_q_lora_norm[j], mla_kv_lora_norm[j], mla_w_uq[j], mla_w_ukv[j],
                             mla_q_gain[j], mla_k_gain[j], dil_q_gain[j], dil_k_gain[j], even_w_out[j],
                             cos32, sin32, cos64, sin64)
        else:
            mix = sparse_mixer(h, odd_w_in[j], sparse_q_gain[j], sparse_k_gain[j], odd_w_out[j], cos64, sin64)
        x = x + mix
        x = x + memory_cross_attention(rms_norm(x, xattn_norm[i]), rms_norm(mem, mem_norm[i]), xattn_wq[i],
                                       xattn_wkv[i], xattn_q_gain[i], xattn_k_gain[i], xattn_wo[i])
        x = x + 0.5 * swiglu(rms_norm(x, ffn2_norm[i]), ffn2_w13[i], ffn2_w2[i])
    return x
```

```cpp
#include <hip/hip_runtime.h>
#include <hip/hip_cooperative_groups.h>
#include <cstdio>
#include <cstdint>
namespace cg = cooperative_groups;
namespace pg8 {
#define PG8_LAS __attribute__((address_space(3)))
typedef unsigned short bf16_t;
typedef short bf16x8 __attribute__((ext_vector_type(8)));
typedef float f32x4 __attribute__((ext_vector_type(4)));
typedef unsigned u32x4 __attribute__((ext_vector_type(4)));
constexpr int BM = 256, BK = 64, HALF = 128, HTB = HALF * BK * 2  , STAGE_BYTES = 8 * HTB, NXCD = 8, WGM = 8;

__host__ __device__ __forceinline__ int lds_byte(int r, int c) { const int st = (r >> 4) * 2 + (c >> 5), rr = r & 15, cc = c & 31, ob = rr * 64 + cc * 2; return st * 1024 + (ob ^ (((ob >> 9) & 1) << 5)); }
__host__ __device__ __forceinline__ void stage_rc(int b, int& R, int& C) { const int st = b / 1024, sb = b % 1024, swz = sb ^ (((sb >> 9) & 1) << 5); R = (st >> 1) * 16 + swz / 64; C = (st & 1) * 32 + (swz % 64) / 2; }
__host__ __device__ __forceinline__ int perm32(int rho) { const int n = rho >> 4, i = rho & 15; return 8 * (i >> 2) + 4 * n + (i & 3); }

struct Unit { int pm, pn; };
struct Gemm { const bf16_t* A; const bf16_t* Bt; int M, N, K, tid; };

struct StaticOrder {
    int nM, nN, nwg, G, c;
    __host__ __device__ void init(int M, int N, int G_, int c_) { nM = M / BM; nN = N / BM; nwg = nM * nN; G = G_; c = c_; }
    __host__ __device__ bool next(int i, Unit& u) const {
        const long L = (long)i * G + c; if (L >= nwg) return false;
        int wgid = (int)L; { const int q = nwg / NXCD, r = nwg % NXCD, xcd = wgid % NXCD, off = wgid / NXCD; wgid = (xcd < r ? xcd * (q + 1) : r * (q + 1) + (xcd - r) * q) + off; }
        const int nig = WGM * nN, gid = wgid / nig, fm = gid * WGM, gsz = (nM - fm) < WGM ? (nM - fm) : WGM;
        u.pm = fm + ((wgid % nig) % gsz); u.pn = (wgid % nig) / gsz; return true;
    }
    __device__ __forceinline__ void a_ready(const Unit&) const {}
    __device__ __forceinline__ void done(const Unit&) const {}
};

__device__ __forceinline__ unsigned cvt_pk_bf16(float lo, float hi) { unsigned r; asm volatile("v_cvt_pk_bf16_f32 %0, %1, %2" : "=v"(r) : "v"(lo), "v"(hi)); return r; }
template <class Epi, class Sched, bool ALIGN_EPI = false, bool SP2 = false>
__device__ __forceinline__ void gemm_phase(PG8_LAS unsigned char* lds, const Gemm g, const Sched& S, const Epi& E) {
    int tid_ = g.tid; asm volatile("" : "+v"(tid_));
    const int tid = tid_, wid = __builtin_amdgcn_readfirstlane(tid >> 6), lane = tid & 63, wr = wid >> 2, wc = wid & 3, fr = lane & 15, fq = lane >> 4;
    const int K = g.K, nt = K / BK;
    unsigned voffA[2], voffB[2];
#pragma unroll
    for (int i = 0; i < 2; ++i) { int R, C; stage_rc(tid * 16 + i * 8192, R, C); const int Rb = Epi::PERM ? ((R & ~31) + perm32(R & 31)) : R;
        voffA[i] = (unsigned)(R * K + C) * 2u; voffB[i] = (unsigned)(Rb * K + C) * 2u; }
    const size_t kstep = (size_t)(BK * 2);
    const size_t hstep = (size_t)HALF * K * 2;
    const size_t tstep = 2 * hstep;
    const unsigned ldsw = (unsigned)wid * 1024u;
    const int aoff = lds_byte(wr * 64 + fr, fq * 8), boff = lds_byte(wc * 32 + fr, fq * 8);
#define PG8_SA(b, h) (((b) * 2 + (h)) * HTB)
#define PG8_SB(b, h) ((4 + (b) * 2 + (h)) * HTB)
#define PG8_STAGE(bufoff, gbase, voff) do { _Pragma("unroll") for (int _i = 0; _i < 2; ++_i) \
        __builtin_amdgcn_global_load_lds((const unsigned*)((const char*)(gbase) + (voff)[_i]), (PG8_LAS unsigned*)(lds + (bufoff) + ldsw + _i * 8192), 16, 0, 0); } while (0)
#define PG8_LDA(dst, b, h) do { _Pragma("unroll") for (int m = 0; m < 4; ++m) _Pragma("unroll") for (int k = 0; k < 2; ++k) dst[m][k] = *(const PG8_LAS bf16x8*)(lds + PG8_SA(b, h) + aoff + m * 2048 + k * 1024); } while (0)
#define PG8_LDB(dst, b, h) do { _Pragma("unroll") for (int n = 0; n < 2; ++n) _Pragma("unroll") for (int k = 0; k < 2; ++k) dst[n][k] = *(const PG8_LAS bf16x8*)(lds + PG8_SB(b, h) + boff + n * 2048 + k * 1024); } while (0)
#define PG8_MMA(ai, bj, At, Bt) do { __builtin_amdgcn_s_setprio(1); _Pragma("unroll") for (int m = 0; m < 4; ++m) _Pragma("unroll") for (int n = 0; n < 2; ++n) _Pragma("unroll") for (int k = 0; k < 2; ++k) \
        acc[ai][bj][m][n] = __builtin_amdgcn_mfma_f32_16x16x32_bf16(Bt[n][k], At[m][k], acc[ai][bj][m][n], 0, 0, 0); __builtin_amdgcn_s_setprio(0); } while (0)
#define PG8_WAIT_V(n) asm volatile("s_waitcnt vmcnt(" #n ")" ::: "memory")
#define PG8_WAIT_L(n) asm volatile("s_waitcnt lgkmcnt(" #n ")" ::: "memory")
#define PG8_BAR __builtin_amdgcn_s_barrier()
#define PG8_SCHED __builtin_amdgcn_sched_barrier(0)
    Unit cur, nxt; int ui = 0;
    if (!S.next(0, cur)) return;
    f32x4 acc[2][2][4][2];
#pragma unroll
    for (int a = 0; a < 2; ++a)
#pragma unroll
        for (int b = 0; b < 2; ++b)
#pragma unroll
            for (int m = 0; m < 4; ++m)
#pragma unroll
                for (int n = 0; n < 2; ++n) acc[a][b][m][n] = (f32x4){0.f, 0.f, 0.f, 0.f};
    bf16x8 At[4][2], B0[2][2], B1[2][2];
    const char* cA = (const char*)g.A + (size_t)cur.pm * tstep; const char* cB = (const char*)g.Bt + (size_t)cur.pn * tstep;
    S.a_ready(cur);
    if constexpr (SP2) {
        PG8_STAGE(PG8_SB(0, 0), cB, voffB); PG8_STAGE(PG8_SB(0, 1), cB + hstep, voffB); PG8_STAGE(PG8_SA(0, 0), cA, voffA); PG8_STAGE(PG8_SA(0, 1), cA + hstep, voffA);
        if (wr == 1) PG8_BAR;
        PG8_WAIT_V(2); PG8_BAR;
        PG8_STAGE(PG8_SB(1, 0), cB + kstep, voffB); PG8_STAGE(PG8_SA(1, 0), cA + kstep, voffA); PG8_STAGE(PG8_SB(1, 1), cB + hstep + kstep, voffB);
        PG8_WAIT_V(6); PG8_BAR;
    } else {
        PG8_STAGE(PG8_SB(0, 0), cB, voffB); PG8_STAGE(PG8_SA(0, 0), cA, voffA); PG8_STAGE(PG8_SB(0, 1), cB + hstep, voffB); PG8_STAGE(PG8_SA(0, 1), cA + hstep, voffA);
        if (wr == 1) PG8_BAR;
        PG8_WAIT_V(4); PG8_BAR;
        PG8_STAGE(PG8_SB(1, 0), cB + kstep, voffB); PG8_STAGE(PG8_SA(1, 0), cA + kstep, voffA); PG8_STAGE(PG8_SB(1, 1), cB + hstep + kstep, voffB);
        PG8_WAIT_V(6); PG8_BAR;
    }
    for (;;) {
        const bool has_next = S.next(ui + 1, nxt);
        const char* nA = has_next ? (const char*)g.A + (size_t)nxt.pm * tstep : cA; const char* nB = has_next ? (const char*)g.Bt + (size_t)nxt.pn * tstep : cB;
        for (int t = 0; t < nt; t += 2) {
            const bool last = (t == nt - 2);
            const char* a1 = cA + (size_t)(t + 1) * kstep;
            const char* a2 = last ? nA : cA + (size_t)(t + 2) * kstep; const char* b2 = last ? nB : cB + (size_t)(t + 2) * kstep;
            const char* a3 = a2 + kstep; const char* b3 = b2 + kstep;
            if (last && has_next) S.a_ready(nxt);
            if constexpr (SP2) {
            PG8_LDB(B0, 0, 0); PG8_LDB(B1, 0, 1); PG8_SCHED; PG8_LDA(At, 0, 0); PG8_STAGE(PG8_SA(1, 1), a1 + hstep, voffA);
            PG8_WAIT_V(8); PG8_WAIT_L(0); PG8_BAR; PG8_MMA(0, 0, At, B0); PG8_MMA(0, 1, At, B1); PG8_BAR; PG8_SCHED;
            PG8_LDA(At, 0, 1); PG8_STAGE(PG8_SB(0, 0), b2, voffB); PG8_STAGE(PG8_SB(0, 1), b2 + hstep, voffB); PG8_STAGE(PG8_SA(0, 0), a2, voffA);
            PG8_WAIT_V(8); PG8_WAIT_L(0); PG8_BAR; PG8_MMA(1, 0, At, B0); PG8_MMA(1, 1, At, B1); PG8_BAR; PG8_SCHED;
            PG8_LDB(B0, 1, 0); PG8_LDB(B1, 1, 1); PG8_SCHED; PG8_LDA(At, 1, 0); PG8_STAGE(PG8_SA(0, 1), a2 + hstep, voffA);
            PG8_WAIT_V(8); PG8_WAIT_L(0); PG8_BAR; PG8_MMA(0, 0, At, B0); PG8_MMA(0, 1, At, B1); PG8_BAR; PG8_SCHED;
            PG8_LDA(At, 1, 1); PG8_STAGE(PG8_SB(1, 0), b3, voffB); PG8_STAGE(PG8_SB(1, 1), b3 + hstep, voffB); PG8_STAGE(PG8_SA(1, 0), a3, voffA);
            PG8_WAIT_V(8); PG8_WAIT_L(0); PG8_BAR; PG8_MMA(1, 0, At, B0); PG8_MMA(1, 1, At, B1); PG8_BAR; PG8_SCHED;
            } else {
            PG8_LDB(B0, 0, 0); PG8_SCHED; PG8_LDA(At, 0, 0); PG8_STAGE(PG8_SA(1, 1), a1 + hstep, voffA);
            PG8_WAIT_L(8); PG8_BAR; PG8_WAIT_L(0); PG8_MMA(0, 0, At, B0); PG8_BAR; PG8_SCHED;
            PG8_LDB(B1, 0, 1); PG8_STAGE(PG8_SB(0, 0), b2, voffB);
            PG8_BAR; PG8_WAIT_L(0); PG8_MMA(0, 1, At, B1); PG8_BAR;
            PG8_LDA(At, 0, 1); PG8_STAGE(PG8_SA(0, 0), a2, voffA);
            PG8_BAR; PG8_WAIT_L(0); PG8_MMA(1, 0, At, B0); PG8_BAR; PG8_SCHED;
            PG8_STAGE(PG8_SB(0, 1), b2 + hstep, voffB);
            PG8_WAIT_V(6); PG8_BAR; PG8_MMA(1, 1, At, B1); PG8_BAR;
            PG8_LDB(B0, 1, 0); PG8_SCHED; PG8_LDA(At, 1, 0); PG8_STAGE(PG8_SA(0, 1), a2 + hstep, voffA);
            PG8_WAIT_L(8); PG8_BAR; PG8_WAIT_L(0); PG8_MMA(0, 0, At, B0); PG8_BAR; PG8_SCHED;
            PG8_LDB(B1, 1, 1); PG8_STAGE(PG8_SB(1, 0), b3, voffB);
            PG8_BAR; PG8_WAIT_L(0); PG8_MMA(0, 1, At, B1); PG8_BAR;
            PG8_LDA(At, 1, 1); PG8_STAGE(PG8_SA(1, 0), a3, voffA);
            PG8_BAR; PG8_WAIT_L(0); PG8_MMA(1, 0, At, B0); PG8_BAR; PG8_SCHED;
            PG8_STAGE(PG8_SB(1, 1), b3 + hstep, voffB);
            PG8_WAIT_V(6); PG8_BAR; PG8_MMA(1, 1, At, B1); PG8_BAR;
            }
        }
        if constexpr (ALIGN_EPI) { if (wr == 0) PG8_BAR; }
        if constexpr (!Epi::AFTER_DRAIN) { E(acc, cur, wr, wc, fr, fq); S.done(cur); }
        if (!has_next) break;
#pragma unroll
        for (int a = 0; a < 2; ++a)
#pragma unroll
            for (int b = 0; b < 2; ++b)
#pragma unroll
                for (int m = 0; m < 4; ++m)
#pragma unroll
                    for (int n = 0; n < 2; ++n) acc[a][b][m][n] = (f32x4){0.f, 0.f, 0.f, 0.f};
        cur = nxt; cA = nA; cB = nB; ++ui;
        if constexpr (ALIGN_EPI) { if (wr == 1) PG8_BAR; }
    }
    PG8_WAIT_V(0);
    if constexpr (!ALIGN_EPI) { if (wr == 0) PG8_BAR; }
    PG8_BAR;
    if constexpr (Epi::AFTER_DRAIN) { E.fused(acc, cur, wr, wc, fr, fq, lds, wid, lane); S.done(cur); }
#undef PG8_SA
#undef PG8_SB
#undef PG8_STAGE
#undef PG8_LDA
#undef PG8_LDB
#undef PG8_MMA
#undef PG8_WAIT_V
#undef PG8_WAIT_L
#undef PG8_BAR
#undef PG8_SCHED
}
}

#define LAS __attribute__((address_space(3)))
typedef unsigned short bf16_t;
typedef short bf16x8 __attribute__((ext_vector_type(8)));
typedef float f32x4 __attribute__((ext_vector_type(4)));
typedef float f32x16 __attribute__((ext_vector_type(16)));
typedef unsigned u32x4 __attribute__((ext_vector_type(4)));
typedef unsigned u32x2 __attribute__((ext_vector_type(2)));
typedef float f32x2 __attribute__((ext_vector_type(2)));

constexpr int T_ = 16384, S_ = 2048, NBATCH = 8, DM = 1024, FF = 2816, MEMLEN = 256, NL = 4;
constexpr int EVEN_IN = 2720, EVEN_INP = 2816, ODD_IN = 1736, ODD_INP = 1792;
constexpr float EPS = 1e-6f, LOG2E = 1.4426950408889634f;
constexpr int LDS_BYTES = 147456;
constexpr int BIGW = 1 << 30;
constexpr int GRID_BLOCKS = 256;

constexpr size_t MiB = 1u << 20;
constexpr size_t WS_W = 0, WS_XKV = 48 * MiB, WS_KX = 64 * MiB, WS_VTX = 80 * MiB, WS_XB = 96 * MiB, WS_SSQ = 128 * MiB, WS_MEMB = 129 * MiB,
                 WS_MEMSSQ = 133 * MiB, WS_CS64 = 134 * MiB, WS_CS32 = 138 * MiB, WS_A = 140 * MiB, WS_B = 228 * MiB, WS_CTL = 377 * MiB, WS_END = 378 * MiB;
constexpr size_t WO_13A = 0, WO_2A = WO_13A + (size_t)5632 * 1024, WO_13B = WO_2A + (size_t)1024 * 2816, WO_2B = WO_13B + (size_t)5632 * 1024,
                 WO_XQ = WO_2B + (size_t)1024 * 2816, WO_XO = WO_XQ + (size_t)1024 * 1024, WO_WIN = WO_XO + (size_t)1024 * 1024,
                 WO_BD = WO_WIN + (size_t)2816 * 1024, WO_WOUT = WO_BD + (size_t)1792 * 384, WO_END = WO_WOUT + (size_t)1024 * 1024;
static_assert(WO_END * 2 <= 48 * MiB, "weights region");
constexpr size_t B_QD = 0, B_KD = 24 * MiB, B_VTD = 48 * MiB, B_QM = 72 * MiB, B_KM = 96 * MiB, B_VTM = 120 * MiB, B_CQKV = 136 * MiB, B_KROPE = 148 * MiB;
constexpr size_t B_QSP = 0, B_QI = 32 * MiB, B_KSP = 48 * MiB, B_VTSP = 50 * MiB, B_KI = 52 * MiB, B_WI = 54 * MiB, B_MASKW = 55 * MiB;
constexpr size_t B_KVRAW = 0;
constexpr size_t A_MIX = 0, A_ODIL = 24 * MiB, A_LSE = 48 * MiB, A_OX = 32 * MiB;

__device__ __forceinline__ unsigned f2bf(float f) { unsigned u = __float_as_uint(f); return (u + 0x7fffu + ((u >> 16) & 1u)) >> 16; }
__device__ __forceinline__ float bf2f(unsigned h) { return __uint_as_float(h << 16); }
__device__ __forceinline__ unsigned pk2(float lo, float hi) { return f2bf(lo) | (f2bf(hi) << 16); }
__device__ __forceinline__ float wave_sum(float v) {
#pragma unroll
    for (int o = 1; o < 64; o <<= 1) v += __shfl_xor(v, o);
    return v;
}
template <int N> __device__ __forceinline__ void wave_sum_n(float (&v)[N]) {
#pragma unroll
    for (int o = 1; o < 64; o <<= 1) {
#pragma unroll
        for (int i = 0; i < N; ++i) v[i] += __shfl_xor(v[i], o);
    }
}
__device__ __forceinline__ float row_rstd16(const float* ssq, int row, float inv_n) {
    const f32x4* p = (const f32x4*)(ssq + (size_t)row * 16);
    const f32x4 a = p[0], b = p[1], c = p[2], d = p[3];
    const float s = ((a[0] + a[1]) + (a[2] + a[3])) + ((b[0] + b[1]) + (b[2] + b[3])) + ((c[0] + c[1]) + (c[2] + c[3])) + ((d[0] + d[1]) + (d[2] + d[3]));
    return __builtin_amdgcn_rsqf(s * inv_n + EPS);
}

__device__ __forceinline__ float row_rstd16_coop(const float* ssq, int row, int fq, float inv_n) {
    const f32x4 a = *(const f32x4*)(ssq + (size_t)row * 16 + fq * 4);
    float s = (a[0] + a[1]) + (a[2] + a[3]);
    s += __shfl_xor(s, 16); s += __shfl_xor(s, 32);
    return __builtin_amdgcn_rsqf(s * inv_n + EPS);
}
namespace pg8 {
struct EpiBf16S {
    static constexpr bool PERM = true, AFTER_DRAIN = false; static constexpr int EID = 0;
    bf16_t* O; int ldc; const float* ssq;
    __device__ __forceinline__ void operator()(const f32x4 (&acc)[2][2][4][2], const Unit& u, int wr, int wc, int fr, int fq) const {
        const int row0 = u.pm * BM + wr * 64 + fr, col0 = u.pn * BM + wc * 32 + 8 * fq;
        float rsv[2][4];
#pragma unroll
        for (int ai = 0; ai < 2; ++ai) {
#pragma unroll
            for (int m = 0; m < 4; ++m) rsv[ai][m] = ssq ? row_rstd16_coop(ssq, row0 + ai * HALF + m * 16, fq, 1.0f / 1024.0f) : 1.0f;
        }
#pragma unroll
        for (int ai = 0; ai < 2; ++ai)
#pragma unroll
            for (int m = 0; m < 4; ++m) {
                const int row = row0 + ai * HALF + m * 16;
                const float rs = rsv[ai][m];
                bf16_t* rowp = O + (size_t)row * ldc + col0;
#pragma unroll
                for (int bj = 0; bj < 2; ++bj) {
                    const f32x4 v0 = acc[ai][bj][m][0] * rs, v1 = acc[ai][bj][m][1] * rs;
                    u32x4 w; w.x = cvt_pk_bf16(v0[0], v0[1]); w.y = cvt_pk_bf16(v0[2], v0[3]); w.z = cvt_pk_bf16(v1[0], v1[1]); w.w = cvt_pk_bf16(v1[2], v1[3]);
                    *(u32x4*)(rowp + bj * HALF) = w;
                }
            }
    }
};
struct EpiSwiGLU {
    static constexpr bool PERM = true, AFTER_DRAIN = false; static constexpr int EID = 1;
    bf16_t* H; int ldh; const float* ssq;
    __device__ __forceinline__ static float sg(float g, float uu) { return g * __builtin_amdgcn_rcpf(1.0f + __builtin_amdgcn_exp2f(-1.4426950408889634f * g)) * uu; }
    __device__ __forceinline__ void operator()(const f32x4 (&acc)[2][2][4][2], const Unit& u, int wr, int wc, int fr, int fq) const {
        const int row0 = u.pm * BM + wr * 64 + fr, col0 = u.pn * BM + wc * 32 + 8 * fq;
        float rsv[2][4];
#pragma unroll
        for (int ai = 0; ai < 2; ++ai) {
#pragma unroll
            for (int m = 0; m < 4; ++m) rsv[ai][m] = row_rstd16_coop(ssq, row0 + ai * HALF + m * 16, fq, 1.0f / 1024.0f);
        }
#pragma unroll
        for (int ai = 0; ai < 2; ++ai)
#pragma unroll
            for (int m = 0; m < 4; ++m) {
                const int row = row0 + ai * HALF + m * 16;
                const float rs = rsv[ai][m];
                bf16_t* rowp = H + (size_t)row * ldh + (col0 >> 1);
#pragma unroll
                for (int bj = 0; bj < 2; ++bj) {
                    const f32x4 v0 = acc[ai][bj][m][0] * rs, v1 = acc[ai][bj][m][1] * rs;
                    u32x2 w; w.x = cvt_pk_bf16(sg(v0[0], v0[1]), sg(v0[2], v0[3])); w.y = cvt_pk_bf16(sg(v1[0], v1[1]), sg(v1[2], v1[3]));
                    *(u32x2*)(rowp + bj * (HALF / 2)) = w;
                }
            }
    }
};
struct EpiResid {
    static constexpr bool PERM = true, AFTER_DRAIN = false; static constexpr int EID = 2;
    const float* Xin; float* X; bf16_t* XB; float* ssq; float scale;
    __device__ __forceinline__ void operator()(const f32x4 (&acc)[2][2][4][2], const Unit& u, int wr, int wc, int fr, int fq) const {
        const int row0 = u.pm * BM + wr * 64 + fr, col0 = u.pn * BM + wc * 32 + 8 * fq;
        f32x4 xv[2][2][2][2];
#define RESID_LOAD(buf, g) do { _Pragma("unroll") for (int rr_ = 0; rr_ < 2; ++rr_) { const int idx_ = 2 * (g) + rr_; const int row_ = row0 + (idx_ >> 2) * HALF + (idx_ & 3) * 16; \
            _Pragma("unroll") for (int bj_ = 0; bj_ < 2; ++bj_) { const f32x4* p_ = (const f32x4*)(Xin + (size_t)row_ * 1024 + col0 + bj_ * HALF); xv[buf][rr_][bj_][0] = p_[0]; xv[buf][rr_][bj_][1] = p_[1]; } } } while (0)
        RESID_LOAD(0, 0);
#pragma unroll
        for (int g = 0; g < 4; ++g) {
            if (g < 3) RESID_LOAD((g + 1) & 1, g + 1);
#pragma unroll
            for (int rr = 0; rr < 2; ++rr) {
                const int idx = 2 * g + rr, ai = idx >> 2, m = idx & 3;
                const int row = row0 + ai * HALF + m * 16;
                float* xr = X + (size_t)row * 1024 + col0; bf16_t* br = XB + (size_t)row * 1024 + col0;
                float ss = 0.f;
#pragma unroll
                for (int bj = 0; bj < 2; ++bj) {
                    f32x4* p = (f32x4*)(xr + bj * HALF);
                    const f32x4 o0 = xv[g & 1][rr][bj][0] + acc[ai][bj][m][0] * scale, o1 = xv[g & 1][rr][bj][1] + acc[ai][bj][m][1] * scale;
                    p[0] = o0; p[1] = o1;
                    u32x4 w; w.x = cvt_pk_bf16(o0[0], o0[1]); w.y = cvt_pk_bf16(o0[2], o0[3]); w.z = cvt_pk_bf16(o1[0], o1[1]); w.w = cvt_pk_bf16(o1[2], o1[3]);
                    *(u32x4*)(br + bj * HALF) = w;
                    ss += (o0[0] * o0[0] + o0[1] * o0[1]) + (o0[2] * o0[2] + o0[3] * o0[3]) + (o1[0] * o1[0] + o1[1] * o1[1]) + (o1[2] * o1[2] + o1[3] * o1[3]);
                }
                ss += __shfl_xor(ss, 16); ss += __shfl_xor(ss, 32);
                if (fq == 0) ssq[(size_t)row * 16 + u.pn * 4 + wc] = ss;
            }
            asm volatile("" ::: "memory");
        }
#undef RESID_LOAD
    }
};
}

template <class Epi> __device__ __forceinline__ void run_gemm(const int tid, LAS unsigned char* lds, const bf16_t* A, const bf16_t* Bt, int M, int N, int K, const Epi& E) {
    asm volatile("" : "+s"(M), "+s"(N), "+s"(K)); asm volatile("" : "+s"(A), "+s"(Bt));
    pg8::Gemm g{A, Bt, M, N, K, tid}; pg8::StaticOrder S; S.init(M, N, (int)gridDim.x, (int)blockIdx.x);
#ifndef SKIP_GEMM
#ifdef REP_GEMM
    { Epi E0 = E; if constexpr (Epi::EID == 2) E0.scale = 0.f; pg8::gemm_phase<Epi, pg8::StaticOrder, true, true>(lds, g, S, E0); }
#endif
    pg8::gemm_phase<Epi, pg8::StaticOrder, true, true>(lds, g, S, E);
#endif
}

__device__ __forceinline__ void conv_item(const float* __restrict__ W, const float* __restrict__ g, int K, int NS, int NP, bf16_t* __restrict__ dst, int ldd, int koff, int row_off, int ilv,
                                          LAS float* scr, int item, int lane) {
    (void)K;
    LAS unsigned char* tile = (LAS unsigned char*)scr;
    const int nblk = (NP + 127) / 128, kb = item / nblk, nb = item % nblk, k0 = 64 * kb, n0 = 128 * nb, n = n0 + lane * 2;
    const bool rd = (W != nullptr) && (n < NS);
#pragma unroll 1
    for (int b2 = 0; b2 < 2; ++b2) {
        f32x2 v[32];
#pragma unroll
        for (int r = 0; r < 32; ++r) {
            const int k = k0 + b2 * 32 + r;
            v[r] = rd ? __builtin_nontemporal_load((const f32x2*)(W + (size_t)k * NS + n)) : (f32x2){0.f, 0.f};
        }
        if (g != nullptr) {
#pragma unroll
            for (int r = 0; r < 32; ++r) v[r] = v[r] * g[k0 + b2 * 32 + r];
        }
#pragma unroll
        for (int i = 0; i < 2; ++i) {
            const int nl = lane * 2 + i;
#pragma unroll
            for (int h = 0; h < 4; ++h) {
                u32x4 o; o.x = pk2(v[h * 8 + 0][i], v[h * 8 + 1][i]); o.y = pk2(v[h * 8 + 2][i], v[h * 8 + 3][i]); o.z = pk2(v[h * 8 + 4][i], v[h * 8 + 5][i]); o.w = pk2(v[h * 8 + 6][i], v[h * 8 + 7][i]);
                *(LAS u32x4*)(tile + nl * 128 + (((b2 * 4 + h) ^ (lane & 7)) << 4)) = o;
            }
        }
    }
    asm volatile("s_waitcnt lgkmcnt(0)" ::: "memory");
#pragma unroll
    for (int j = 0; j < 16; ++j) {
        const int idx = j * 64 + lane, nl = idx >> 3, q = idx & 7, nn = n0 + nl;
        const u32x4 o = *(const LAS u32x4*)(tile + nl * 128 + ((q ^ ((nl >> 1) & 7)) << 4));
        if (nn < NP) {
            const int drow = row_off + (ilv ? (nn < ilv ? 2 * nn : 2 * (nn - ilv) + 1) : nn);
            *(u32x4*)(dst + (size_t)drow * ldd + koff + k0 + q * 8) = o;
        }
    }
    asm volatile("s_waitcnt lgkmcnt(0)" ::: "memory");
}

__device__ __forceinline__ int crow(int r, int hi) { return (r & 3) + 8 * (r >> 2) + 4 * hi; }

template <int DQK, int DV, int MODE, bool QNORM, bool PF>
__device__ __forceinline__ void attn_tile(const bf16_t* __restrict__ Qp, int q_pitch, const bf16_t* __restrict__ Kp, int k_pitch,
                                          const bf16_t* __restrict__ Vt, int vt_pitch, int kt_lo, int kt_hi, int q0, int qoff, int W,
                                          const unsigned* __restrict__ mw, float qk_scale, f32x16 (&o)[DV / 32], float& m_out, float& l_out, const int lane) {
    const int r32 = lane & 31, hi = lane >> 5;
    bf16x8 qf[DQK / 16];
#pragma unroll
    for (int d0 = 0; d0 < DQK / 16; ++d0) qf[d0] = *(const bf16x8*)(Qp + (size_t)r32 * q_pitch + d0 * 16 + hi * 8);
    float sscale = 1.0f;
    if (QNORM) {
        float ss = 0.f;
#pragma unroll
        for (int d0 = 0; d0 < DQK / 16; ++d0)
#pragma unroll
            for (int j = 0; j < 8; ++j) { const float v = bf2f((unsigned)(unsigned short)qf[d0][j]); ss += v * v; }
        ss += __shfl_xor(ss, 32);
        sscale = qk_scale * __builtin_amdgcn_rsqf(ss * (1.0f / DQK) + EPS);
    }
    float m_run = 0.f, l_run = 0.f;
#pragma unroll
    for (int dt = 0; dt < DV / 32; ++dt)
#pragma unroll
        for (int r = 0; r < 16; ++r) o[dt][r] = 0.f;
    const bf16_t* kbase = Kp + (size_t)r32 * k_pitch + hi * 8;
    const bf16_t* vbase = Vt + (size_t)r32 * vt_pitch + hi * 8;
    const unsigned* mbase = (MODE == 1) ? (mw + (size_t)r32 * 64) : nullptr;
    bf16x8 kf[DQK / 16], vf[DV / 32][2]; unsigned w = 0xffffffffu;
#define ATT_LOAD(KF, VF, WW, kt_) do { const bf16_t* kb_ = kbase + (size_t)(kt_) * 32 * k_pitch; \
        _Pragma("unroll") for (int d0 = 0; d0 < DQK / 16; ++d0) KF[d0] = *(const bf16x8*)(kb_ + d0 * 16); \
        _Pragma("unroll") for (int dt = 0; dt < DV / 32; ++dt) _Pragma("unroll") for (int ks = 0; ks < 2; ++ks) VF[dt][ks] = *(const bf16x8*)(vbase + (size_t)dt * 32 * vt_pitch + (kt_) * 32 + ks * 16); \
        if (MODE == 1) WW = mbase[kt_]; } while (0)
    if (PF) { if (kt_lo < kt_hi) ATT_LOAD(kf, vf, w, kt_lo); }
    for (int kt = kt_lo; kt < kt_hi; ++kt) {
        bf16x8 kfn[PF ? DQK / 16 : 1], vfn[PF ? DV / 32 : 1][2]; unsigned wn = 0xffffffffu;
        if (PF) { if (kt + 1 < kt_hi) ATT_LOAD(kfn, vfn, wn, kt + 1); }
        else ATT_LOAD(kf, vf, w, kt);
        f32x16 s;
#pragma unroll
        for (int r = 0; r < 16; ++r) s[r] = 0.f;
#pragma unroll
        for (int d0 = 0; d0 < DQK / 16; ++d0) s = __builtin_amdgcn_mfma_f32_32x32x16_bf16(kf[d0], qf[d0], s, 0, 0, 0);
#pragma unroll
        for (int r = 0; r < 16; ++r) s[r] = QNORM ? (s[r] * sscale - m_run) : (s[r] - m_run);
        if (MODE == 0) {
            const int dmax = q0 + 31 + qoff - kt * 32, dmin = q0 + qoff - kt * 32 - 31;
            if (!(dmin >= 0 && dmax <= W)) {
#pragma unroll
                for (int r = 0; r < 16; ++r) { const int d = q0 + r32 + qoff - (kt * 32 + crow(r, hi)); if ((unsigned)d > (unsigned)W) s[r] = -INFINITY; }
            }
        } else {
#pragma unroll
            for (int r = 0; r < 16; ++r) { if (((w >> crow(r, hi)) & 1u) == 0u) s[r] = -INFINITY; }
        }
        float tm = s[0];
#pragma unroll
        for (int r = 1; r < 16; ++r) tm = fmaxf(tm, s[r]);
        tm = fmaxf(tm, __shfl_xor(tm, 32));
        if (__ballot(tm > 0.f) != 0ull) {
            const float dl = fmaxf(tm, 0.f); m_run += dl;
            const float alpha = __builtin_amdgcn_exp2f(-dl);
            l_run *= alpha;
#pragma unroll
            for (int r = 0; r < 16; ++r) s[r] -= dl;
#pragma unroll
            for (int dt = 0; dt < DV / 32; ++dt)
#pragma unroll
                for (int r = 0; r < 16; ++r) o[dt][r] *= alpha;
        }
        float ps = 0.f;
#pragma unroll
        for (int r = 0; r < 16; ++r) { s[r] = __builtin_amdgcn_exp2f(s[r]); ps += s[r]; }
        l_run += ps;
        u32x4 p0, p1;
        p0.x = pg8::cvt_pk_bf16(s[0], s[1]); p0.y = pg8::cvt_pk_bf16(s[2], s[3]); p0.z = pg8::cvt_pk_bf16(s[4], s[5]); p0.w = pg8::cvt_pk_bf16(s[6], s[7]);
        p1.x = pg8::cvt_pk_bf16(s[8], s[9]); p1.y = pg8::cvt_pk_bf16(s[10], s[11]); p1.z = pg8::cvt_pk_bf16(s[12], s[13]); p1.w = pg8::cvt_pk_bf16(s[14], s[15]);
        const bf16x8 pf0 = __builtin_bit_cast(bf16x8, p0), pf1 = __builtin_bit_cast(bf16x8, p1);
#pragma unroll
        for (int dt = 0; dt < DV / 32; ++dt) {
            o[dt] = __builtin_amdgcn_mfma_f32_32x32x16_bf16(vf[dt][0], pf0, o[dt], 0, 0, 0);
            o[dt] = __builtin_amdgcn_mfma_f32_32x32x16_bf16(vf[dt][1], pf1, o[dt], 0, 0, 0);
        }
        if (PF) {
#pragma unroll
            for (int d0 = 0; d0 < DQK / 16; ++d0) kf[d0] = kfn[PF ? d0 : 0];
#pragma unroll
            for (int dt = 0; dt < DV / 32; ++dt) { vf[dt][0] = vfn[PF ? dt : 0][0]; vf[dt][1] = vfn[PF ? dt : 0][1]; }
            w = wn;
        }
    }
#undef ATT_LOAD
    l_run += __shfl_xor(l_run, 32);
    m_out = m_run; l_out = l_run;
}
template <int DQK, int DV, int MODE, bool QNORM, int SK, int NQ>
__device__ __forceinline__ void attn_block(LAS unsigned char* lds, const bf16_t* __restrict__ Qp, int q_pitch, int q_hoff, const bf16_t* __restrict__ Kp, int k_pitch,
                                           const bf16_t* __restrict__ Vt, int vt_pitch, int nst, int nst_w, int q0, const unsigned* __restrict__ mw, float qk_scale,
                                           f32x16 (&o)[NQ][DV / 32], float (&m_out)[NQ], float (&l_out)[NQ], const int tid) {
    constexpr int NSUB = SK / 32, KP = DQK * 2 + 16, VP = SK * 2 + 16, KBYTES = SK * KP, VBYTES = DV * VP, STAGE = KBYTES + VBYTES;
    constexpr int KCPR = DQK / 8, VCPR = SK / 8, KCH = SK * KCPR, VCH = DV * VCPR, NCH = KCH + VCH, NLD = (NCH + 511) / 512;
    static_assert(2 * STAGE <= 131072, "attention stages fit the ring region");
    const int lane = tid & 63, r32 = lane & 31, hi = lane >> 5;
    bf16x8 qf[NQ][DQK / 16];
#pragma unroll
    for (int qh = 0; qh < NQ; ++qh)
#pragma unroll
        for (int d0 = 0; d0 < DQK / 16; ++d0) qf[qh][d0] = *(const bf16x8*)(Qp + (size_t)qh * q_hoff + (size_t)r32 * q_pitch + d0 * 16 + hi * 8);
    float sscale[NQ];
#pragma unroll
    for (int qh = 0; qh < NQ; ++qh) {
        sscale[qh] = 1.0f;
        if (QNORM) {
            float ss = 0.f;
#pragma unroll
            for (int d0 = 0; d0 < DQK / 16; ++d0)
#pragma unroll
                for (int jq = 0; jq < 8; ++jq) { const float v = bf2f((unsigned)(unsigned short)qf[qh][d0][jq]); ss += v * v; }
            ss += __shfl_xor(ss, 32);
            sscale[qh] = qk_scale * __builtin_amdgcn_rsqf(ss * (1.0f / DQK) + EPS);
        }
    }
    float m_run[NQ], l_run[NQ];
#pragma unroll
    for (int qh = 0; qh < NQ; ++qh) {
        m_run[qh] = 0.f; l_run[qh] = 0.f;
#pragma unroll
        for (int dt = 0; dt < DV / 32; ++dt)
#pragma unroll
            for (int r = 0; r < 16; ++r) o[qh][dt][r] = 0.f;
    }
    int goff[NLD]; bool isk[NLD]; int gstep[NLD]; int ldst[NLD]; bool act[NLD];
#pragma unroll
    for (int i = 0; i < NLD; ++i) {
        const int c = tid + i * 512; act[i] = c < NCH;
        isk[i] = c < KCH;
        if (c < KCH) { const int row = c / KCPR, ch = c % KCPR; goff[i] = row * k_pitch + ch * 8; gstep[i] = SK * k_pitch; ldst[i] = row * KP + ch * 16; }
        else { const int c2 = c - KCH, row = c2 / VCPR, ch = c2 % VCPR; goff[i] = (row < DV ? row : 0) * vt_pitch + ch * 8; gstep[i] = SK; ldst[i] = KBYTES + row * VP + ch * 16; }
    }
    constexpr bool PF2 = (NQ == 1 && DQK <= 96);
    u32x4 stg[NLD], stg2[NLD];
    const int nstage = (nst + NSUB - 1) / NSUB;
#pragma unroll
    for (int i = 0; i < NLD; ++i) if (act[i]) stg2[i] = *(const u32x4*)((isk[i] ? Kp : Vt) + goff[i]);
    if (PF2 && 1 < nstage) {
#pragma unroll
        for (int i = 0; i < NLD; ++i) if (act[i]) stg[i] = *(const u32x4*)((isk[i] ? Kp : Vt) + goff[i] + gstep[i]);
    }
#pragma unroll
    for (int i = 0; i < NLD; ++i) if (act[i]) *(LAS u32x4*)(lds + ldst[i]) = stg2[i];
    unsigned wcur0 = 0xffffffffu, wcur1 = 0xffffffffu;
    const unsigned* mrow = (MODE == 1) ? (mw + (size_t)r32 * 64) : nullptr;
    if (MODE == 1) { wcur0 = mrow[0]; wcur1 = (NSUB > 1 && 1 < nst) ? mrow[1] : 0u; }
    __syncthreads();
    for (int sg = 0; sg < nstage; ++sg) {
        const bool more = sg + 1 < nstage;
        unsigned wn0 = 0xffffffffu, wn1 = 0xffffffffu;
        if (PF2) {
            if (sg + 2 < nstage) {
#pragma unroll
                for (int i = 0; i < NLD; ++i) if (act[i]) stg2[i] = *(const u32x4*)((isk[i] ? Kp : Vt) + goff[i] + (sg + 2) * gstep[i]);
            }
        } else if (more) {
#pragma unroll
            for (int i = 0; i < NLD; ++i) if (act[i]) stg[i] = *(const u32x4*)((isk[i] ? Kp : Vt) + goff[i] + (sg + 1) * gstep[i]);
        }
        if (more) {
            if (MODE == 1) { wn0 = mrow[NSUB * sg + NSUB]; wn1 = (NSUB > 1 && NSUB * sg + NSUB + 1 < nst) ? mrow[NSUB * sg + NSUB + 1] : 0u; }
        }
        LAS unsigned char* sb = lds + (sg & 1) * STAGE;
        if (NSUB * sg < nst_w) {
            f32x16 sc[NQ][NSUB];
#pragma unroll
            for (int qh = 0; qh < NQ; ++qh)
#pragma unroll
                for (int sub = 0; sub < NSUB; ++sub)
#pragma unroll
                    for (int r = 0; r < 16; ++r) sc[qh][sub][r] = QNORM ? 0.f : -m_run[qh];
            if (NQ == 1 && DQK <= 96) {
                bf16x8 kfa[NSUB][DQK / 16];
#pragma unroll
                for (int d0 = 0; d0 < DQK / 16; ++d0)
#pragma unroll
                    for (int sub = 0; sub < NSUB; ++sub) kfa[sub][d0] = *(const LAS bf16x8*)(sb + (sub * 32 + r32) * KP + hi * 16 + d0 * 32);
                asm volatile("s_waitcnt lgkmcnt(0)" ::: "memory");
                __builtin_amdgcn_sched_barrier(0);
                __builtin_amdgcn_s_setprio(1);
#pragma unroll
                for (int d0 = 0; d0 < DQK / 16; ++d0)
#pragma unroll
                    for (int sub = 0; sub < NSUB; ++sub) sc[0][sub] = __builtin_amdgcn_mfma_f32_32x32x16_bf16(kfa[sub][d0], qf[0][d0], sc[0][sub], 0, 0, 0);
            } else {
            __builtin_amdgcn_s_setprio(1);
#pragma unroll
            for (int d0 = 0; d0 < DQK / 16; ++d0)
#pragma unroll
                for (int sub = 0; sub < NSUB; ++sub) {
                    const bf16x8 kf = *(const LAS bf16x8*)(sb + (sub * 32 + r32) * KP + hi * 16 + d0 * 32);
#pragma unroll
                    for (int qh = 0; qh < NQ; ++qh) sc[qh][sub] = __builtin_amdgcn_mfma_f32_32x32x16_bf16(kf, qf[qh][d0], sc[qh][sub], 0, 0, 0);
                }
            }
            __builtin_amdgcn_s_setprio(0);
#pragma unroll
            for (int sub = 0; sub < NSUB; ++sub) {
                const int st = NSUB * sg + sub;
                if (QNORM) {
#pragma unroll
                    for (int qh = 0; qh < NQ; ++qh)
#pragma unroll
                        for (int r = 0; r < 16; ++r) sc[qh][sub][r] = sc[qh][sub][r] * sscale[qh] - m_run[qh];
                }
                if (MODE == 0) {
                    if (st * 32 + 31 > q0) {
#pragma unroll
                        for (int r = 0; r < 16; ++r) { if (st * 32 + crow(r, hi) > q0 + r32) {
#pragma unroll
                            for (int qh = 0; qh < NQ; ++qh) sc[qh][sub][r] = -INFINITY; } }
                    }
                } else if (MODE == 1) {
                    const unsigned w = sub ? wcur1 : wcur0;
#pragma unroll
                    for (int r = 0; r < 16; ++r) { if (((w >> crow(r, hi)) & 1u) == 0u) {
#pragma unroll
                        for (int qh = 0; qh < NQ; ++qh) sc[qh][sub][r] = -INFINITY; } }
                } else if (st >= nst_w) {
#pragma unroll
                    for (int qh = 0; qh < NQ; ++qh)
#pragma unroll
                        for (int r = 0; r < 16; ++r) sc[qh][sub][r] = -INFINITY;
                }
            }
            bf16x8 pf[NQ][NSUB][2];
#pragma unroll
            for (int qh = 0; qh < NQ; ++qh) {
                float tm = sc[qh][0][0];
#pragma unroll
                for (int sub = 0; sub < NSUB; ++sub)
#pragma unroll
                    for (int r = 0; r < 16; ++r) tm = fmaxf(tm, sc[qh][sub][r]);
                tm = fmaxf(tm, __shfl_xor(tm, 32));
                if (__ballot(tm > 0.f) != 0ull) {
                    const float dl = fmaxf(tm, 0.f); m_run[qh] += dl;
                    const float alpha = __builtin_amdgcn_exp2f(-dl);
                    l_run[qh] *= alpha;
#pragma unroll
                    for (int sub = 0; sub < NSUB; ++sub)
#pragma unroll
                        for (int r = 0; r < 16; ++r) sc[qh][sub][r] -= dl;
#pragma unroll
                    for (int dt = 0; dt < DV / 32; ++dt)
#pragma unroll
                        for (int r = 0; r < 16; ++r) o[qh][dt][r] *= alpha;
                }
                float ps = 0.f;
#pragma unroll
                for (int sub = 0; sub < NSUB; ++sub)
#pragma unroll
                    for (int r = 0; r < 16; ++r) { sc[qh][sub][r] = __builtin_amdgcn_exp2f(sc[qh][sub][r]); ps += sc[qh][sub][r]; }
                l_run[qh] += ps;
#pragma unroll
                for (int sub = 0; sub < NSUB; ++sub) {
                    u32x4 p0, p1;
                    p0.x = pg8::cvt_pk_bf16(sc[qh][sub][0], sc[qh][sub][1]); p0.y = pg8::cvt_pk_bf16(sc[qh][sub][2], sc[qh][sub][3]); p0.z = pg8::cvt_pk_bf16(sc[qh][sub][4], sc[qh][sub][5]); p0.w = pg8::cvt_pk_bf16(sc[qh][sub][6], sc[qh][sub][7]);
                    p1.x = pg8::cvt_pk_bf16(sc[qh][sub][8], sc[qh][sub][9]); p1.y = pg8::cvt_pk_bf16(sc[qh][sub][10], sc[qh][sub][11]); p1.z = pg8::cvt_pk_bf16(sc[qh][sub][12], sc[qh][sub][13]); p1.w = pg8::cvt_pk_bf16(sc[qh][sub][14], sc[qh][sub][15]);
                    pf[qh][sub][0] = __builtin_bit_cast(bf16x8, p0); pf[qh][sub][1] = __builtin_bit_cast(bf16x8, p1);
                }
            }
            __builtin_amdgcn_s_setprio(1);
#pragma unroll
            for (int sub = 0; sub < NSUB; ++sub) {
                const LAS unsigned char* vb = sb + KBYTES + r32 * VP + (sub * 32 + hi * 8) * 2;
#pragma unroll
                for (int dt = 0; dt < DV / 32; ++dt) {
                    const bf16x8 v0 = *(const LAS bf16x8*)(vb + dt * 32 * VP), v1 = *(const LAS bf16x8*)(vb + dt * 32 * VP + 32);
#pragma unroll
                    for (int qh = 0; qh < NQ; ++qh) {
                        o[qh][dt] = __builtin_amdgcn_mfma_f32_32x32x16_bf16(v0, pf[qh][sub][0], o[qh][dt], 0, 0, 0);
                        o[qh][dt] = __builtin_amdgcn_mfma_f32_32x32x16_bf16(v1, pf[qh][sub][1], o[qh][dt], 0, 0, 0);
                    }
                }
            }
            __builtin_amdgcn_s_setprio(0);
        }
        if (more) {
            LAS unsigned char* nb = lds + ((sg + 1) & 1) * STAGE;
#pragma unroll
            for (int i = 0; i < NLD; ++i) if (act[i]) *(LAS u32x4*)(nb + ldst[i]) = stg[i];
            if (PF2) {
#pragma unroll
                for (int i = 0; i < NLD; ++i) stg[i] = stg2[i];
            }
            wcur0 = wn0; wcur1 = wn1;
        }
        __syncthreads();
    }
#pragma unroll
    for (int qh = 0; qh < NQ; ++qh) { l_run[qh] += __shfl_xor(l_run[qh], 32); m_out[qh] = m_run[qh]; l_out[qh] = l_run[qh]; }
}
template <int DV> __device__ __forceinline__ void store_ot(const f32x16 (&o)[DV / 32], float inv_l, bf16_t* orow, int hi) {
#pragma unroll
    for (int dt = 0; dt < DV / 32; ++dt)
#pragma unroll
        for (int a = 0; a < 4; ++a) {
            u32x2 w; w.x = pk2(o[dt][4 * a] * inv_l, o[dt][4 * a + 1] * inv_l); w.y = pk2(o[dt][4 * a + 2] * inv_l, o[dt][4 * a + 3] * inv_l);
            *(u32x2*)(orow + dt * 32 + 8 * a + 4 * hi) = w;
        }
}

template <int DIL> __device__ __forceinline__ void vt_item(const bf16_t* __restrict__ src, size_t src_pitch, bf16_t* __restrict__ dstrow, int s0, int L, int lane) {
    unsigned v[64];
#pragma unroll
    for (int i = 0; i < 64; ++i) v[i] = __builtin_nontemporal_load(src + (size_t)i * src_pitch + lane);
    const int mb = s0 / DIL;
#pragma unroll
    for (int r = 0; r < DIL; ++r)
#pragma unroll
        for (int q4 = 0; q4 < 16 / DIL; ++q4) {
            const int m_base = mb + 4 * q4, pidx = r * L + m_base, a = (m_base >> 2) & 3, slot = 8 * (a & 1) + 4 * (a >> 1);
            u32x2 w; w.x = v[(4 * q4 + 0) * DIL + r] | (v[(4 * q4 + 1) * DIL + r] << 16); w.y = v[(4 * q4 + 2) * DIL + r] | (v[(4 * q4 + 3) * DIL + r] << 16);
            *(u32x2*)(dstrow + (pidx & ~15) + slot) = w;
        }
}

template <int D> __device__ __forceinline__ void head_vec(const bf16_t* __restrict__ src, const float* __restrict__ g0, const float* __restrict__ g1, bool sel1, bool norm, bool rope,
                                                          float scale, const f32x2* __restrict__ cs, bf16_t* __restrict__ dst) {
    float v[D];
#pragma unroll
    for (int q = 0; q < D / 8; ++q) {
        const u32x4 raw = *(const u32x4*)(src + 8 * q);
        v[8 * q + 0] = bf2f(raw.x & 0xffffu); v[8 * q + 1] = bf2f(raw.x >> 16); v[8 * q + 2] = bf2f(raw.y & 0xffffu); v[8 * q + 3] = bf2f(raw.y >> 16);
        v[8 * q + 4] = bf2f(raw.z & 0xffffu); v[8 * q + 5] = bf2f(raw.z >> 16); v[8 * q + 6] = bf2f(raw.w & 0xffffu); v[8 * q + 7] = bf2f(raw.w >> 16);
    }
    float ss = 0.f;
#pragma unroll
    for (int d = 0; d < D; ++d) ss += v[d] * v[d];
    const float rs = norm ? __builtin_amdgcn_rsqf(ss * (1.0f / D) + EPS) : 1.0f;
#pragma unroll
    for (int d = 0; d < D; ++d) { const float gg = norm ? (sel1 ? g1[d] : g0[d]) : 1.0f; v[d] = v[d] * rs * gg; }
#pragma unroll
    for (int i = 0; i < D / 4; ++i) {
        const f32x4 c2 = *(const f32x4*)(cs + 2 * i);
#pragma unroll
        for (int e = 0; e < 2; ++e) {
            const int d = 2 * i + e; const float cc = rope ? c2[2 * e] : 1.0f, sn = rope ? c2[2 * e + 1] : 0.0f;
            const float a = v[d], b = v[d + D / 2];
            v[d] = (a * cc - b * sn) * scale; v[d + D / 2] = (b * cc + a * sn) * scale;
        }
    }
#pragma unroll
    for (int q = 0; q < D / 8; ++q) {
        u32x4 w; w.x = pg8::cvt_pk_bf16(v[8 * q], v[8 * q + 1]); w.y = pg8::cvt_pk_bf16(v[8 * q + 2], v[8 * q + 3]); w.z = pg8::cvt_pk_bf16(v[8 * q + 4], v[8 * q + 5]); w.w = pg8::cvt_pk_bf16(v[8 * q + 6], v[8 * q + 7]);
        *(u32x4*)(dst + 8 * q) = w;
    }
}

template <int D> __device__ __forceinline__ void head_vec8(const bf16_t* __restrict__ src, const float* __restrict__ gain, bool norm, bool rope, float scale,
                                                           const f32x2* __restrict__ cs, bf16_t* __restrict__ dst, const int sub) {
    constexpr int NH = D / 16;
    float lo[NH], hi[NH];
    if (NH == 4) {
        const u32x2 a = *(const u32x2*)(src + sub * 4), b = *(const u32x2*)(src + D / 2 + sub * 4);
        lo[0] = bf2f(a.x & 0xffffu); lo[1] = bf2f(a.x >> 16); lo[NH - 2] = bf2f(a.y & 0xffffu); lo[NH - 1] = bf2f(a.y >> 16);
        hi[0] = bf2f(b.x & 0xffffu); hi[1] = bf2f(b.x >> 16); hi[NH - 2] = bf2f(b.y & 0xffffu); hi[NH - 1] = bf2f(b.y >> 16);
    } else {
        const unsigned a = *(const unsigned*)(src + sub * 2), b = *(const unsigned*)(src + D / 2 + sub * 2);
        lo[0] = bf2f(a & 0xffffu); lo[1] = bf2f(a >> 16); hi[0] = bf2f(b & 0xffffu); hi[1] = bf2f(b >> 16);
    }
    float ss = 0.f;
#pragma unroll
    for (int i = 0; i < NH; ++i) ss += lo[i] * lo[i] + hi[i] * hi[i];
    ss += __shfl_xor(ss, 1); ss += __shfl_xor(ss, 2); ss += __shfl_xor(ss, 4);
    const float rs = norm ? __builtin_amdgcn_rsqf(ss * (1.0f / D) + EPS) : 1.0f;
    float cc[NH], sn[NH];
    if (NH == 4) {
        const f32x4 g0 = *(const f32x4*)(gain + sub * 4), g1 = *(const f32x4*)(gain + D / 2 + sub * 4);
        const f32x4 c0 = *(const f32x4*)(cs + sub * 4), c1 = *(const f32x4*)(cs + sub * 4 + 2);
#pragma unroll
        for (int i = 0; i < 4; ++i) { lo[i] *= norm ? rs * g0[i] : 1.0f; hi[i] *= norm ? rs * g1[i] : 1.0f; }
        cc[0] = c0[0]; sn[0] = c0[1]; cc[1] = c0[2]; sn[1] = c0[3]; cc[NH - 2] = c1[0]; sn[NH - 2] = c1[1]; cc[NH - 1] = c1[2]; sn[NH - 1] = c1[3];
    } else {
        const f32x2 g0 = *(const f32x2*)(gain + sub * 2), g1 = *(const f32x2*)(gain + D / 2 + sub * 2);
        const f32x4 c0 = *(const f32x4*)(cs + sub * 2);
#pragma unroll
        for (int i = 0; i < 2; ++i) { lo[i] *= norm ? rs * g0[i] : 1.0f; hi[i] *= norm ? rs * g1[i] : 1.0f; }
        cc[0] = c0[0]; sn[0] = c0[1]; cc[1] = c0[2]; sn[1] = c0[3];
    }
    float ol[NH], oh[NH];
#pragma unroll
    for (int i = 0; i < NH; ++i) {
        const float c = rope ? cc[i] : 1.0f, sv = rope ? sn[i] : 0.0f;
        ol[i] = (lo[i] * c - hi[i] * sv) * scale; oh[i] = (hi[i] * c + lo[i] * sv) * scale;
    }
    if (NH == 4) {
        u32x2 w0, w1; w0.x = pg8::cvt_pk_bf16(ol[0], ol[1]); w0.y = pg8::cvt_pk_bf16(ol[NH - 2], ol[NH - 1]); w1.x = pg8::cvt_pk_bf16(oh[0], oh[1]); w1.y = pg8::cvt_pk_bf16(oh[NH - 2], oh[NH - 1]);
        *(u32x2*)(dst + sub * 4) = w0; *(u32x2*)(dst + D / 2 + sub * 4) = w1;
    } else {
        *(unsigned*)(dst + sub * 2) = pg8::cvt_pk_bf16(ol[0], ol[1]); *(unsigned*)(dst + D / 2 + sub * 2) = pg8::cvt_pk_bf16(oh[0], oh[1]);
    }
}

struct HVRaw { u32x2 a, b; f32x4 g0, g1, c0, c1; };
template <int D> __device__ __forceinline__ void hv_load(HVRaw& r, const bf16_t* __restrict__ src, const float* __restrict__ gain, const f32x2* __restrict__ cs, const int sub) {
    if (D == 64) {
        r.a = __builtin_nontemporal_load((const u32x2*)(src + sub * 4)); r.b = __builtin_nontemporal_load((const u32x2*)(src + 32 + sub * 4));
        r.g0 = *(const f32x4*)(gain + sub * 4); r.g1 = *(const f32x4*)(gain + 32 + sub * 4);
        r.c0 = *(const f32x4*)(cs + sub * 4); r.c1 = *(const f32x4*)(cs + sub * 4 + 2);
    } else {
        r.a.x = *(const unsigned*)(src + sub * 2); r.b.x = *(const unsigned*)(src + 16 + sub * 2); r.a.y = 0u; r.b.y = 0u;
        const f32x2 g0 = *(const f32x2*)(gain + sub * 2), g1 = *(const f32x2*)(gain + 16 + sub * 2);
        r.g0 = (f32x4){g0.x, g0.y, 0.f, 0.f}; r.g1 = (f32x4){g1.x, g1.y, 0.f, 0.f};
        r.c0 = *(const f32x4*)(cs + sub * 2); r.c1 = r.c0;
    }
}
template <int D> __device__ __forceinline__ void hv_finish(const HVRaw& r, bool norm, bool rope, float scale, bf16_t* __restrict__ dst, const int sub) {
    constexpr int NH = D / 16;
    float lo[4], hi[4], cc[4], sn[4];
    lo[0] = bf2f(r.a.x & 0xffffu); lo[1] = bf2f(r.a.x >> 16); lo[2] = bf2f(r.a.y & 0xffffu); lo[3] = bf2f(r.a.y >> 16);
    hi[0] = bf2f(r.b.x & 0xffffu); hi[1] = bf2f(r.b.x >> 16); hi[2] = bf2f(r.b.y & 0xffffu); hi[3] = bf2f(r.b.y >> 16);
    float ss = 0.f;
#pragma unroll
    for (int i = 0; i < NH; ++i) ss += lo[i] * lo[i] + hi[i] * hi[i];
    ss += __shfl_xor(ss, 1); ss += __shfl_xor(ss, 2); ss += __shfl_xor(ss, 4);
    const float rs = norm ? __builtin_amdgcn_rsqf(ss * (1.0f / D) + EPS) : 1.0f;
#pragma unroll
    for (int i = 0; i < NH; ++i) { lo[i] *= norm ? rs * r.g0[i] : 1.0f; hi[i] *= norm ? rs * r.g1[i] : 1.0f; }
    cc[0] = r.c0[0]; sn[0] = r.c0[1]; cc[1] = r.c0[2]; sn[1] = r.c0[3]; cc[2] = r.c1[0]; sn[2] = r.c1[1]; cc[3] = r.c1[2]; sn[3] = r.c1[3];
    float ol[4], oh[4];
#pragma unroll
    for (int i = 0; i < NH; ++i) {
        const float c = rope ? cc[i] : 1.0f, sv = rope ? sn[i] : 0.0f;
        ol[i] = (lo[i] * c - hi[i] * sv) * scale; oh[i] = (hi[i] * c + lo[i] * sv) * scale;
    }
    if (NH == 4) {
        u32x2 w0, w1; w0.x = pg8::cvt_pk_bf16(ol[0], ol[1]); w0.y = pg8::cvt_pk_bf16(ol[2], ol[3]); w1.x = pg8::cvt_pk_bf16(oh[0], oh[1]); w1.y = pg8::cvt_pk_bf16(oh[2], oh[3]);
        *(u32x2*)(dst + sub * 4) = w0; *(u32x2*)(dst + 32 + sub * 4) = w1;
    } else {
        *(unsigned*)(dst + sub * 2) = pg8::cvt_pk_bf16(ol[0], ol[1]); *(unsigned*)(dst + 16 + sub * 2) = pg8::cvt_pk_bf16(oh[0], oh[1]);
    }
}

template <int D> __device__ __forceinline__ void norm_vec(const bf16_t* __restrict__ src, const float* __restrict__ gain, bf16_t* __restrict__ dst, const int sub) {
    const u32x4 raw = *(const u32x4*)(src + sub * 8);
    float v[8];
    v[0] = bf2f(raw.x & 0xffffu); v[1] = bf2f(raw.x >> 16); v[2] = bf2f(raw.y & 0xffffu); v[3] = bf2f(raw.y >> 16);
    v[4] = bf2f(raw.z & 0xffffu); v[5] = bf2f(raw.z >> 16); v[6] = bf2f(raw.w & 0xffffu); v[7] = bf2f(raw.w >> 16);
    float ss = 0.f;
#pragma unroll
    for (int i = 0; i < 8; ++i) ss += v[i] * v[i];
#pragma unroll
    for (int o = 1; o < D / 8; o <<= 1) ss += __shfl_xor(ss, o);
    const float rs = __builtin_amdgcn_rsqf(ss * (1.0f / D) + EPS);
    const f32x4 g0 = *(const f32x4*)(gain + sub * 8), g1 = *(const f32x4*)(gain + sub * 8 + 4);
    u32x4 w; w.x = pg8::cvt_pk_bf16(v[0] * rs * g0[0], v[1] * rs * g0[1]); w.y = pg8::cvt_pk_bf16(v[2] * rs * g0[2], v[3] * rs * g0[3]);
    w.z = pg8::cvt_pk_bf16(v[4] * rs * g1[0], v[5] * rs * g1[1]); w.w = pg8::cvt_pk_bf16(v[6] * rs * g1[2], v[7] * rs * g1[3]);
    *(u32x4*)(dst + sub * 8) = w;
}

__device__ __forceinline__ float rope_apply(float y, float partner, f32x2 cs, bool first_half) { return first_half ? y * cs.x - partner * cs.y : y * cs.x + partner * cs.y; }

#define XB_TMO      128
#define XB_XCNT(j)  (256  + 64 * (j))
#define XB_XSUB(j)  (1280 + 64 * (j))
#define XB_XGEN(j)  (2304 + 64 * (j))
#define XB_TOP      3328
#define XB_TOPGEN   3392
#define XCD_BAR_WORDS 3456
#define XB_SPIN_CAP (1u << 18)

__device__ __forceinline__ unsigned xb_ld(unsigned* p)              { return __hip_atomic_load(p, __ATOMIC_RELAXED, __HIP_MEMORY_SCOPE_AGENT); }
__device__ __forceinline__ unsigned xb_add(unsigned* p, unsigned v) { return __hip_atomic_fetch_add(p, v, __ATOMIC_RELAXED, __HIP_MEMORY_SCOPE_AGENT); }
__device__ __forceinline__ unsigned xb_xcc_id() { return (unsigned)__builtin_amdgcn_s_getreg((3 << 11) | 20) & 0xFu; }
#define XB_SPIN(cond, bar) do { unsigned _sp = 0; while (cond) { __builtin_amdgcn_s_sleep(1); \
    if ((++_sp & 255u) == 0u) { if (xb_ld(&(bar)[XB_TMO])) break; if (_sp > XB_SPIN_CAP) { atomicAdd(&(bar)[XB_TMO], 1u); break; } } } } while (0)

struct XcdBarrier {
    unsigned* bar; unsigned x; unsigned tid;
    volatile LAS unsigned* st;
};

__device__ __forceinline__ XcdBarrier xcd_barrier_post(unsigned* bar, volatile LAS unsigned* st) {
    XcdBarrier b; b.bar = bar; b.x = xb_xcc_id(); b.st = st; b.tid = threadIdx.x;
    if (threadIdx.x == 0) (void)xb_add(&bar[XB_XCNT(b.x)], 1u);
    return b;
}
__device__ __forceinline__ void xcd_barrier_complete(unsigned* bar, unsigned x, unsigned& nloc, unsigned& nx) {
    const unsigned G = gridDim.x * gridDim.y * gridDim.z;
    unsigned sum, cnt, mine, sp = 0u;
    for (;;) {
        sum = 0u; cnt = 0u; mine = 0u;
#pragma unroll
        for (unsigned j = 0; j < 16; ++j) { const unsigned c = xb_ld(&bar[XB_XCNT(j)]); sum += c; cnt += (c > 0u) ? 1u : 0u; mine = (j == x) ? c : mine; }
        if (sum == G) break;
        __builtin_amdgcn_s_sleep(1);
        if ((++sp & 255u) == 0u) { if (xb_ld(&bar[XB_TMO])) break; if (sp > XB_SPIN_CAP) { atomicAdd(&bar[XB_TMO], 1u); break; } }
    }
    nloc = mine > 0u ? mine : 1u; nx = cnt > 0u ? cnt : 1u;
}

__device__ __forceinline__ void xcd_barrier(const XcdBarrier& b) {
    asm volatile("s_waitcnt vmcnt(0)" ::: "memory");
    __syncthreads();
    if (b.tid == 0u) {
        unsigned* bar = b.bar;
        __builtin_amdgcn_s_waitcnt(0);
        unsigned nloc = b.st[0], nx = b.st[1];
        if (nloc == 0u) { xcd_barrier_complete(bar, b.x, nloc, nx); b.st[0] = nloc; b.st[1] = nx; }
        const unsigned old = xb_add(&bar[XB_XSUB(b.x)], 1u);
        const unsigned gen = old / nloc;
        if (old + 1u == (gen + 1u) * nloc) {
            __builtin_amdgcn_fence(__ATOMIC_RELEASE, "agent");
            asm volatile("s_waitcnt vmcnt(0)" ::: "memory");
            const unsigned og = xb_add(&bar[XB_TOP], 1u);
            const unsigned tg = og / nx;
            if (og + 1u == (tg + 1u) * nx) xb_add(&bar[XB_TOPGEN], 1u);
            else XB_SPIN(xb_ld(&bar[XB_TOPGEN]) == tg, bar);
            __builtin_amdgcn_fence(__ATOMIC_ACQUIRE, "agent");
            xb_add(&bar[XB_XGEN(b.x)], 1u);
            asm volatile("s_waitcnt vmcnt(0)" ::: "memory");
        } else {
            XB_SPIN(xb_ld(&bar[XB_XGEN(b.x)]) == gen, bar);
            __builtin_amdgcn_fence(__ATOMIC_ACQUIRE, "agent");
            asm volatile("s_waitcnt vmcnt(0)" ::: "memory");
        }
    }
    __syncthreads();
}

struct KArgs { const void* in[31]; float* out; unsigned char* ws; };

__global__ void __launch_bounds__(512, 2) mega_fwd(KArgs a) {
    extern __shared__ __attribute__((aligned(16))) unsigned char lds_raw[];
    LAS unsigned char* lds = (LAS unsigned char*)lds_raw;
    cg::grid_group grid = cg::this_grid();
    const int wave_s = __builtin_amdgcn_readfirstlane((int)(threadIdx.x >> 6));
#define TIDX (wave_s * 64 + (int)__builtin_amdgcn_mbcnt_hi(~0u, __builtin_amdgcn_mbcnt_lo(~0u, 0u)))
#ifdef REP_ATT
#define ATT_REP for (int rep_ = 0; rep_ < 2; ++rep_)
#else
#define ATT_REP
#endif
#ifdef REP_IDX
#define IDX_REP for (int rep_ = 0; rep_ < 2; ++rep_)
#else
#define IDX_REP
#endif
#ifdef REP_EWA
#define EWA_REP for (int rep_ = 0; rep_ < 2; ++rep_)
#else
#define EWA_REP
#endif
#ifdef REP_EWB
#define EWB_REP for (int rep_ = 0; rep_ < 2; ++rep_)
#else
#define EWB_REP
#endif
#define PH_VARS KA_DEF int tid = TIDX; asm volatile("" : "+v"(tid)); const int lane = tid & 63, wave = __builtin_amdgcn_readfirstlane(tid >> 6); \
    const int gw = blockIdx.x * 8 + wave; constexpr int NGW = GRID_BLOCKS * 8; const int r32 = lane & 31, hi = lane >> 5; LAS float* scr = (LAS float*)(lds + wave * 16384); \
    (void)gw; (void)NGW; (void)r32; (void)hi; (void)scr;

#define KA_DEF const __attribute__((address_space(4))) KArgs* ka_ = (const __attribute__((address_space(4))) KArgs*)__builtin_amdgcn_kernarg_segment_ptr(); asm volatile("" : "+s"(ka_));
#define KA_ ka_
#define INF(k) ((const float*)KA_->in[k])
#define x_in INF(0)
#define mem_in INF(1)
#define pos_in ((const int*)KA_->in[2])
#define ffn1_norm INF(3)
#define ffn1_w13 INF(4)
#define ffn1_w2 INF(5)
#define mix_norm INF(6)
#define xattn_norm INF(7)
#define mem_norm INF(8)
#define xattn_wq INF(9)
#define xattn_wkv INF(10)
#define xattn_qg INF(11)
#define xattn_kg INF(12)
#define xattn_wo INF(13)
#define ffn2_norm INF(14)
#define ffn2_w13 INF(15)
#define ffn2_w2 INF(16)
#define even_w_in INF(17)
#define mla_qlora_g INF(18)
#define mla_kvlora_g INF(19)
#define mla_w_uq INF(20)
#define mla_w_ukv INF(21)
#define mla_q_g INF(22)
#define mla_k_g INF(23)
#define dil_q_g INF(24)
#define dil_k_g INF(25)
#define even_w_out INF(26)
#define odd_w_in INF(27)
#define sp_q_g INF(28)
#define sp_k_g INF(29)
#define odd_w_out INF(30)
#define X (KA_->out)
#define WSP(off) (KA_->ws + (off))
#define Wl ((bf16_t*)WSP(WS_W))
#define XKV ((bf16_t*)WSP(WS_XKV))
#define KX ((bf16_t*)WSP(WS_KX))
#define VTX ((bf16_t*)WSP(WS_VTX))
#define XB ((bf16_t*)WSP(WS_XB))
#define SSQ ((float*)WSP(WS_SSQ))
#define MEMB ((bf16_t*)WSP(WS_MEMB))
#define MEMSSQ ((float*)WSP(WS_MEMSSQ))
#define CS64 ((f32x2*)WSP(WS_CS64))
#define CS32 ((f32x2*)WSP(WS_CS32))
#define RA ((bf16_t*)WSP(WS_A))
#define QD ((bf16_t*)WSP(WS_B + B_QD))
#define KD ((bf16_t*)WSP(WS_B + B_KD))
#define VTD ((bf16_t*)WSP(WS_B + B_VTD))
#define QM ((bf16_t*)WSP(WS_B + B_QM))
#define KM ((bf16_t*)WSP(WS_B + B_KM))
#define VTM ((bf16_t*)WSP(WS_B + B_VTM))
#define CQKV ((bf16_t*)WSP(WS_B + B_CQKV))
#define KROPE ((bf16_t*)WSP(WS_B + B_KROPE))
#define QSP ((bf16_t*)WSP(WS_B + B_QSP))
#define QI ((bf16_t*)WSP(WS_B + B_QI))
#define KSP ((bf16_t*)WSP(WS_B + B_KSP))
#define VTSP ((bf16_t*)WSP(WS_B + B_VTSP))
#define KI ((bf16_t*)WSP(WS_B + B_KI))
#define WI ((float*)WSP(WS_B + B_WI))
#define MASKW ((unsigned*)WSP(WS_B + B_MASKW))
#define KVRAW ((bf16_t*)WSP(WS_B + B_KVRAW))
#define MIX ((bf16_t*)WSP(WS_A + A_MIX))
#define ODIL ((bf16_t*)WSP(WS_A + A_ODIL))
#define LSE ((float*)WSP(WS_A + A_LSE))
#define OX ((bf16_t*)WSP(WS_A + A_OX))

    volatile LAS unsigned* MISC = (volatile LAS unsigned*)(lds + 131072 + 320);
    if (threadIdx.x < 32) MISC[threadIdx.x] = 0u;
    __syncthreads();
    { KA_DEF (void)xcd_barrier_post((unsigned*)WSP(WS_CTL), MISC + 8); }
#define XSYNC() do { KA_DEF XcdBarrier b_; b_.tid = (unsigned)TIDX; b_.bar = (unsigned*)WSP(WS_CTL); b_.x = xb_xcc_id(); b_.st = (volatile LAS unsigned*)(lds + 131072 + 320) + 8; xcd_barrier(b_); } while (0)
#ifdef REP_SYNC
#define GSYNC() do { XSYNC(); XSYNC(); } while (0)
#else
#define GSYNC() XSYNC()
#endif
#define CONV_JOB(Wp, Gp, KK, NS, NP, DSTP, LDD, KOFF, ROFF, ILV) { const int ni_ = ((KK) / 64) * (((NP) + 127) / 128); \
        if (r < ni_) { conv_item(Wp, Gp, KK, NS, NP, DSTP, LDD, KOFF, ROFF, ILV, scr, r, lane); continue; } r -= ni_; }
#define CONV_LAYER(l) do { const int l_ = (l), j_ = l_ >> 1; const bool ev_ = (l_ & 1) == 0; \
        for (int it = gw;; it += NGW) { int r = it; \
            CONV_JOB(ffn1_w13 + (size_t)l_ * 1024 * 5632, ffn1_norm + l_ * 1024, 1024, 5632, 5632, Wl + WO_13A, 1024, 0, 0, FF) \
            CONV_JOB(ffn1_w2 + (size_t)l_ * 2816 * 1024, (const float*)nullptr, 2816, 1024, 1024, Wl + WO_2A, 2816, 0, 0, 0) \
            CONV_JOB(ffn2_w13 + (size_t)l_ * 1024 * 5632, ffn2_norm + l_ * 1024, 1024, 5632, 5632, Wl + WO_13B, 1024, 0, 0, FF) \
            CONV_JOB(ffn2_w2 + (size_t)l_ * 2816 * 1024, (const float*)nullptr, 2816, 1024, 1024, Wl + WO_2B, 2816, 0, 0, 0) \
            CONV_JOB(xattn_wq + (size_t)l_ * 1024 * 1024, xattn_norm + l_ * 1024, 1024, 1024, 1024, Wl + WO_XQ, 1024, 0, 0, 0) \
            CONV_JOB(xattn_wo + (size_t)l_ * 1024 * 1024, (const float*)nullptr, 1024, 1024, 1024, Wl + WO_XO, 1024, 0, 0, 0) \
            if (ev_) { \
                CONV_JOB(even_w_in + (size_t)j_ * 1024 * EVEN_IN, mix_norm + l_ * 1024, 1024, EVEN_IN, EVEN_INP, Wl + WO_WIN, 1024, 0, 0, 0) \
                CONV_JOB(mla_w_uq + (size_t)j_ * 256 * 768, (const float*)nullptr, 256, 768, 768, Wl + WO_BD, 384, 0, 0, 0) \
                CONV_JOB(mla_w_ukv + (size_t)j_ * 128 * 1024, (const float*)nullptr, 128, 1024, 1024, Wl + WO_BD, 384, 256, 768, 0) \
                CONV_JOB((const float*)nullptr, (const float*)nullptr, 128, 768, 768, Wl + WO_BD, 384, 256, 0, 0) \
                CONV_JOB((const float*)nullptr, (const float*)nullptr, 256, 1024, 1024, Wl + WO_BD, 384, 0, 768, 0) \
                CONV_JOB(even_w_out + (size_t)j_ * 768 * 1024, (const float*)nullptr, 768, 1024, 1024, Wl + WO_WOUT, 768, 0, 0, 0) \
            } else { \
                CONV_JOB(odd_w_in + (size_t)j_ * 1024 * ODD_IN, mix_norm + l_ * 1024, 1024, ODD_IN, ODD_INP, Wl + WO_WIN, 1024, 0, 0, 0) \
                CONV_JOB(odd_w_out + (size_t)j_ * 1024 * 1024, (const float*)nullptr, 1024, 1024, 1024, Wl + WO_WOUT, 1024, 0, 0, 0) \
            } \
            break; } } while (0)

    { PH_VARS EWA_REP {
    CONV_LAYER(0);
    for (int it = gw;; it += NGW) { int r = it;
        CONV_JOB(xattn_wkv + (size_t)0 * 1024 * 2048, mem_norm + 0 * 1024, 1024, 2048, 2048, XKV + (size_t)0 * 2048 * 1024, 1024, 0, 0, 0)
        CONV_JOB(xattn_wkv + (size_t)1 * 1024 * 2048, mem_norm + 1 * 1024, 1024, 2048, 2048, XKV + (size_t)1 * 2048 * 1024, 1024, 0, 0, 0)
        CONV_JOB(xattn_wkv + (size_t)2 * 1024 * 2048, mem_norm + 2 * 1024, 1024, 2048, 2048, XKV + (size_t)2 * 2048 * 1024, 1024, 0, 0, 0)
        CONV_JOB(xattn_wkv + (size_t)3 * 1024 * 2048, mem_norm + 3 * 1024, 1024, 2048, 2048, XKV + (size_t)3 * 2048 * 1024, 1024, 0, 0, 0)
        break; }
    for (int m0 = gw; m0 < T_ + NBATCH * MEMLEN; m0 += 2 * NGW) {
        f32x4 v[2][4]; bool ok[2];
#pragma unroll
        for (int u2 = 0; u2 < 2; ++u2) {
            const int m = m0 + u2 * NGW; ok[u2] = m < T_ + NBATCH * MEMLEN;
            const bool is_x = m < T_; const int row = is_x ? m : m - T_;
            const f32x4* xr = (const f32x4*)((is_x ? x_in : mem_in) + (size_t)row * DM) + lane;
#pragma unroll
            for (int j = 0; j < 4; ++j) v[u2][j] = ok[u2] ? xr[64 * j] : (f32x4){0.f, 0.f, 0.f, 0.f};
        }
#pragma unroll
        for (int u2 = 0; u2 < 2; ++u2) {
            const int m = m0 + u2 * NGW;
            const bool is_x = m < T_; const int row = is_x ? m : m - T_;
            float sacc = 0.f;
#pragma unroll
            for (int j = 0; j < 4; ++j) sacc += (v[u2][j][0] * v[u2][j][0] + v[u2][j][1] * v[u2][j][1]) + (v[u2][j][2] * v[u2][j][2] + v[u2][j][3] * v[u2][j][3]);
            sacc = wave_sum(sacc);
            if (ok[u2]) {
                bf16_t* ob = (is_x ? XB : MEMB) + (size_t)row * DM; float* sq = (is_x ? SSQ : MEMSSQ) + (size_t)row * 16;
#pragma unroll
                for (int j = 0; j < 4; ++j) {
                    u32x2 w; w.x = pk2(v[u2][j][0], v[u2][j][1]); w.y = pk2(v[u2][j][2], v[u2][j][3]);
                    ((u32x2*)ob + lane)[64 * j] = w;
                }
                if (lane < 16) sq[lane] = (lane == 0) ? sacc : 0.f;
            }
        }
    }
    for (int e = blockIdx.x * 512 + tid; e < T_ * 48; e += GRID_BLOCKS * 512) {
        const int t = e / 48, c = e % 48; const bool is64 = c < 32; const int i = is64 ? c : c - 32; const int dim = is64 ? 64 : 32;
        const float ex = (-9.210340371976184f * (float)(2 * i)) / (float)dim;
        const float inv = expf(ex);
        const float ang = (float)pos_in[t] * inv;
        const double ad = (double)ang; const double kq = rint(ad * 0.6366197723675814); const double rr = ad - kq * 1.5707963267948966;
        const double r2 = rr * rr;
        const double sn = rr * (1.0 + r2 * (-1.0 / 6 + r2 * (1.0 / 120 + r2 * (-1.0 / 5040 + r2 * (1.0 / 362880 + r2 * (-1.0 / 39916800))))));
        const double cn = 1.0 + r2 * (-0.5 + r2 * (1.0 / 24 + r2 * (-1.0 / 720 + r2 * (1.0 / 40320 + r2 * (-1.0 / 3628800 + r2 * (1.0 / 479001600))))));
        const int q = ((int)kq) & 3;
        const double cc = (q == 0) ? cn : (q == 1) ? -sn : (q == 2) ? -cn : sn;
        const double sv = (q == 0) ? sn : (q == 1) ? cn : (q == 2) ? -sn : -cn;
        f32x2 o; o.x = (float)cc; o.y = (float)sv;
        if (is64) CS64[(size_t)t * 32 + i] = o; else CS32[(size_t)t * 16 + i] = o;
    }
    } }
    if (gridDim.y == 0x7fffu) grid.sync();
    GSYNC();

    { KA_DEF pg8::EpiBf16S E{KVRAW, 8192, MEMSSQ}; run_gemm(TIDX, lds, MEMB, XKV, NBATCH * MEMLEN, 8192, 1024, E); }
    GSYNC();
    { PH_VARS EWA_REP {
    for (int e = gw * 64 + lane; e < NL * 2048 * 4 * 32; e += NGW * 64) {
        const int vec = e >> 5, sub = lane & 31, h = vec & 3, row = (vec >> 2) & 2047, l = vec >> 13, b = row >> 8, m = row & 255;
        const u32x4 raw = *(const u32x4*)(KVRAW + (size_t)row * 8192 + l * 2048 + h * 256 + sub * 8);
        const f32x4 k0 = *(const f32x4*)(xattn_kg + l * 256 + sub * 8), k1 = *(const f32x4*)(xattn_kg + l * 256 + sub * 8 + 4);
        const f32x4 q0 = *(const f32x4*)(xattn_qg + l * 256 + sub * 8), q1 = *(const f32x4*)(xattn_qg + l * 256 + sub * 8 + 4);
        float v[8];
        v[0] = bf2f(raw.x & 0xffffu); v[1] = bf2f(raw.x >> 16); v[2] = bf2f(raw.y & 0xffffu); v[3] = bf2f(raw.y >> 16);
        v[4] = bf2f(raw.z & 0xffffu); v[5] = bf2f(raw.z >> 16); v[6] = bf2f(raw.w & 0xffffu); v[7] = bf2f(raw.w >> 16);
        float ss = 0.f;
#pragma unroll
        for (int i = 0; i < 8; ++i) ss += v[i] * v[i];
        ss += __shfl_xor(ss, 1); ss += __shfl_xor(ss, 2); ss += __shfl_xor(ss, 4); ss += __shfl_xor(ss, 8); ss += __shfl_xor(ss, 16);
        const float rs = __builtin_amdgcn_rsqf(ss * (1.0f / 256.0f) + EPS);
        u32x4 w; w.x = pg8::cvt_pk_bf16(v[0] * rs * k0[0] * q0[0], v[1] * rs * k0[1] * q0[1]); w.y = pg8::cvt_pk_bf16(v[2] * rs * k0[2] * q0[2], v[3] * rs * k0[3] * q0[3]);
        w.z = pg8::cvt_pk_bf16(v[4] * rs * k1[0] * q1[0], v[5] * rs * k1[1] * q1[1]); w.w = pg8::cvt_pk_bf16(v[6] * rs * k1[2] * q1[2], v[7] * rs * k1[3] * q1[3]);
        *(u32x4*)(KX + ((size_t)((l * 8 + b) * 4 + h) * 256 + m) * 256 + sub * 8) = w;
    }
    for (int it = gw; it < 2048; it += NGW) {
        const int dq = it & 3, ch = (it >> 2) & 3, h = (it >> 4) & 3, b = (it >> 6) & 7, l = it >> 9;
        const bf16_t* src = KVRAW + (size_t)(b * 256 + ch * 64) * 8192 + l * 2048 + 1024 + h * 256 + dq * 64;
        bf16_t* dst = VTX + ((size_t)((l * 8 + b) * 4 + h) * 256 + dq * 64 + lane) * 256;
        vt_item<1>(src, 8192, dst, ch * 64, 256, lane);
    }
    } }
    GSYNC();

#pragma unroll 1
    for (int l = 0; l < NL; ++l) {
        const int j = l >> 1; const bool even = (l & 1) == 0;
        if (l > 0) { { PH_VARS EWA_REP { CONV_LAYER(l); } } GSYNC(); }
        { KA_DEF pg8::EpiSwiGLU E{RA, FF, SSQ}; run_gemm(TIDX, lds, XB, Wl + WO_13A, T_, 2 * FF, 1024, E); }
        GSYNC();
        { KA_DEF pg8::EpiResid E{(l == 0) ? x_in : (const float*)X, X, XB, SSQ, 0.5f}; run_gemm(TIDX, lds, RA, Wl + WO_2A, T_, 1024, FF, E); }
        GSYNC();
        const int ldc = even ? EVEN_INP : ODD_INP;
        { KA_DEF pg8::EpiBf16S E{RA, ldc, SSQ}; run_gemm(TIDX, lds, XB, Wl + WO_WIN, T_, ldc, 1024, E); }
        GSYNC();
        if (even) {
            { PH_VARS EWB_REP {
            const float* qlg = mla_qlora_g + j * 256; const float* kvlg = mla_kvlora_g + j * 128; const float* mkg = mla_k_g + j * 96;
            const float* dqg = dil_q_g + j * 64; const float* dkg = dil_k_g + j * 64;
            for (int e = gw * 64 + lane; e < T_ * 32; e += NGW * 64) {
                const int t = e >> 5;
                norm_vec<256>(RA + (size_t)t * EVEN_INP, qlg, CQKV + (size_t)t * 384, lane & 31);
            }
            for (int e = gw * 64 + lane; e < T_ * 16; e += NGW * 64) {
                const int t = e >> 4;
                norm_vec<128>(RA + (size_t)t * EVEN_INP + 256, kvlg, CQKV + (size_t)t * 384 + 256, lane & 15);
            }
            for (int e = gw * 64 + lane; e < T_ * 8; e += NGW * 64) {
                const int t = e >> 3;
                head_vec8<32>(RA + (size_t)t * EVEN_INP + 384, mkg + 64, true, true, 1.0f, CS32 + (size_t)t * 16, KROPE + (size_t)t * 32, lane & 7);
            }
            for (int e0 = gw * 64 + lane; e0 < T_ * 24 * 8; e0 += NGW * 64 * 4) {
                HVRaw hr[4]; bf16_t* dsts[4]; bool isk[4];
#pragma unroll
                for (int u4 = 0; u4 < 4; ++u4) {
                    const int ev = (e0 + u4 * NGW * 64) >> 3, t = ev / 24, gq = ev - t * 24, g = gq >> 3, qk = (gq >> 2) & 1, h = gq & 3, b = t >> 11, sq = t & 2047;
                    const int sh = (g == 0) ? 0 : (g == 1) ? 2 : 4;
                    const int pi = ((sq & ((1 << sh) - 1)) << (11 - sh)) + (sq >> sh);
                    dsts[u4] = (qk ? KD : QD) + ((size_t)((b * 3 + g) * 4 + h) * 2048 + pi) * 64; isk[u4] = qk != 0;
                    hv_load<64>(hr[u4], RA + (size_t)t * EVEN_INP + 416 + ((g * 3 + qk) * 4 + h) * 64, qk ? dkg : dqg, CS64 + (size_t)t * 32, lane & 7);
                }
#pragma unroll
                for (int u4 = 0; u4 < 4; ++u4) hv_finish<64>(hr[u4], true, true, isk[u4] ? 1.0f : 0.125f * LOG2E, dsts[u4], lane & 7);
            }
            for (int it = gw; it < 8 * 32 * 12; it += NGW) {
                const int gh = it % 12, ch = (it / 12) & 31, b = it / (12 * 32), g = gh >> 2, h = gh & 3;
                const bf16_t* src = RA + (size_t)(b * S_ + ch * 64) * EVEN_INP + 416 + ((g * 3 + 2) * 4 + h) * 64;
                bf16_t* dst = VTD + ((size_t)((b * 3 + g) * 4 + h) * 64 + lane) * 2048;
                if (g == 0) vt_item<1>(src, EVEN_INP, dst, ch * 64, 2048, lane);
                else if (g == 1) vt_item<4>(src, EVEN_INP, dst, ch * 64, 512, lane);
                else vt_item<16>(src, EVEN_INP, dst, ch * 64, 128, lane);
            }
            } }
            GSYNC();
            { KA_DEF pg8::EpiBf16S E{RA, 1792, nullptr}; run_gemm(TIDX, lds, CQKV, Wl + WO_BD, T_, 1792, 384, E); }
            GSYNC();
            { PH_VARS EWB_REP {
            const float* mqg = mla_q_g + j * 96; const float* mkg = mla_k_g + j * 96;
            const float SCQ = 0.10206207261596577f * LOG2E;
            for (int e0 = gw * 64 + lane; e0 < T_ * 16 * 8; e0 += NGW * 64 * 4) {
                HVRaw hr[4]; bf16_t* dsts[4]; bool isk[4];
#pragma unroll
                for (int u4 = 0; u4 < 4; ++u4) {
                    const int ev = (e0 + u4 * NGW * 64) >> 3, t = ev >> 4, which = (ev >> 3) & 1, h = ev & 7;
                    dsts[u4] = (which ? KM : QM) + ((size_t)t * 8 + h) * 96; isk[u4] = which != 0;
                    hv_load<64>(hr[u4], RA + (size_t)t * 1792 + (which ? 768 + h * 128 : h * 96), which ? mkg : mqg, CS64, lane & 7);
                }
#pragma unroll
                for (int u4 = 0; u4 < 4; ++u4) hv_finish<64>(hr[u4], true, false, isk[u4] ? 1.0f : SCQ, dsts[u4], lane & 7);
            }
            for (int e0 = gw * 64 + lane; e0 < T_ * 8 * 8; e0 += NGW * 64 * 2) {
                HVRaw hr[2]; u32x2 kr[2];
                const int sub = lane & 7;
#pragma unroll
                for (int u2 = 0; u2 < 2; ++u2) {
                    const int ev = (e0 + u2 * NGW * 64) >> 3, t = ev >> 3, h = ev & 7;
                    hv_load<32>(hr[u2], RA + (size_t)t * 1792 + h * 96 + 64, mqg + 64, CS32 + (size_t)t * 16, sub);
                    kr[u2] = *(const u32x2*)(KROPE + (size_t)t * 32 + sub * 4);
                }
#pragma unroll
                for (int u2 = 0; u2 < 2; ++u2) {
                    const int ev = (e0 + u2 * NGW * 64) >> 3, t = ev >> 3, h = ev & 7;
                    hv_finish<32>(hr[u2], true, true, SCQ, QM + ((size_t)t * 8 + h) * 96 + 64, sub);
                    *(u32x2*)(KM + ((size_t)t * 8 + h) * 96 + 64 + sub * 4) = kr[u2];
                }
            }
            for (int it = gw; it < 8 * 32 * 8; it += NGW) {
                const int h = it & 7, ch = (it >> 3) & 31, b = it >> 8;
                const bf16_t* src = RA + (size_t)(b * S_ + ch * 64) * 1792 + 768 + h * 128 + 64;
                bf16_t* dst = VTM + ((size_t)(b * 8 + h) * 64 + lane) * 2048;
                vt_item<1>(src, 1792, dst, ch * 64, 2048, lane);
            }
            } }
            GSYNC();
            { PH_VARS
            ATT_REP
            for (int ub = blockIdx.x; ub < 512; ub += GRID_BLOCKS) {
                const int pass = ub >> 8, idx = ub & 255, bh = idx & 63, i = idx >> 6, qb = pass ? i : 7 - i, b = bh >> 3, h = bh & 7;
                const int qt = qb * 8 + wave, q0 = qt * 32;
                f32x16 o[1][2]; float mm[1], ll[1];
                attn_block<96, 64, 0, false, 64, 1>(lds, QM + ((size_t)(b * S_ + q0) * 8 + h) * 96, 768, 0, KM + ((size_t)b * S_ * 8 + h) * 96, 768,
                                      VTM + (size_t)(b * 8 + h) * 64 * 2048, 2048, qb * 8 + 8, qt + 1, q0, nullptr, 0.f, o, mm, ll, tid);
                store_ot<64>(o[0], 1.0f / ll[0], MIX + (size_t)(b * S_ + q0 + r32) * 768 + h * 64, hi);
            }
            for (int u = gw; u < 6144; u += NGW) {
                f32x16 o[2]; float mm, ll;
                {
                    const int v = u, g = v >> 11, rest = v & 2047, qtile = rest & 63, b = (rest >> 6) & 7, h = rest >> 9;
                    const int sh = (g == 0) ? 0 : (g == 1) ? 2 : 4, Lg = 2048 >> sh, p0 = qtile * 32, rr = p0 / Lg, m0 = p0 % Lg;
                    const size_t base = (size_t)((b * 3 + g) * 4 + h);
                    const int ktl = (m0 >> 5) - 4 < 0 ? 0 : (m0 >> 5) - 4;
                    attn_tile<64, 64, 0, false, true>(QD + (base * 2048 + p0) * 64, 64, KD + (base * 2048 + (size_t)rr * Lg) * 64, 64,
                                                VTD + base * 64 * 2048 + (size_t)rr * Lg, 2048, ktl, (m0 >> 5) + 1, m0, 0, 128, nullptr, 0.f, o, mm, ll, lane);
                    const int s = ((m0 + r32) << sh) + rr; const size_t t = (size_t)b * S_ + s;
                    store_ot<64>(o, 1.0f / ll, ODIL + (t * 12 + g * 4 + h) * 64, hi);
                    if (hi == 0) LSE[t * 12 + g * 4 + h] = mm + log2f(ll);
                }
            }
            }
            GSYNC();
            { PH_VARS EWB_REP {
            for (int e = gw * 64 + lane; e < T_ * 32; e += NGW * 64) {
                const int t = e >> 5, h = (e >> 3) & 3, ch = e & 7;
                const float l0 = LSE[(size_t)t * 12 + h], l1 = LSE[(size_t)t * 12 + 4 + h], l2 = LSE[(size_t)t * 12 + 8 + h];
                const u32x4 a0 = *(const u32x4*)(ODIL + ((size_t)t * 12 + h) * 64 + ch * 8), a1 = *(const u32x4*)(ODIL + ((size_t)t * 12 + 4 + h) * 64 + ch * 8), a2 = *(const u32x4*)(ODIL + ((size_t)t * 12 + 8 + h) * 64 + ch * 8);
                const float mx = fmaxf(l0, fmaxf(l1, l2));
                float w0 = __builtin_amdgcn_exp2f(l0 - mx), w1 = __builtin_amdgcn_exp2f(l1 - mx), w2 = __builtin_amdgcn_exp2f(l2 - mx);
                const float inv = __builtin_amdgcn_rcpf(w0 + w1 + w2); w0 *= inv; w1 *= inv; w2 *= inv;
                u32x4 o;
#pragma unroll
                for (int q = 0; q < 4; ++q) {
                    const float lo = w0 * bf2f(a0[q] & 0xffffu) + w1 * bf2f(a1[q] & 0xffffu) + w2 * bf2f(a2[q] & 0xffffu);
                    const float hi2 = w0 * bf2f(a0[q] >> 16) + w1 * bf2f(a1[q] >> 16) + w2 * bf2f(a2[q] >> 16);
                    o[q] = pg8::cvt_pk_bf16(lo, hi2);
                }
                *(u32x4*)(MIX + (size_t)t * 768 + 512 + h * 64 + ch * 8) = o;
            }
            } }
            GSYNC();
            { KA_DEF pg8::EpiResid E{X, X, XB, SSQ, 1.0f}; run_gemm(TIDX, lds, MIX, Wl + WO_WOUT, T_, 1024, 768, E); }
            GSYNC();
        } else {
            { PH_VARS EWB_REP {
            const float* qg = sp_q_g + j * 64; const float* kg = sp_k_g + j * 64;
            for (int e0 = gw * 64 + lane; e0 < T_ * 26 * 8; e0 += NGW * 64 * 2) {
                HVRaw hr[2]; bf16_t* dsts[2]; int hhs[2];
#pragma unroll
                for (int u2 = 0; u2 < 2; ++u2) {
                    const int ev = (e0 + u2 * NGW * 64) >> 3, t = ev / 26, hh = ev - t * 26;
                    const int off = (hh < 16) ? hh * 64 : (hh == 16) ? 1024 : (hh < 25) ? 1152 + (hh - 17) * 64 : 1664;
                    dsts[u2] = (hh < 16) ? QSP + ((size_t)t * 16 + hh) * 64 : (hh == 16) ? KSP + (size_t)t * 64 : (hh < 25) ? QI + ((size_t)t * 8 + (hh - 17)) * 64 : KI + (size_t)t * 64;
                    hhs[u2] = hh;
                    hv_load<64>(hr[u2], RA + (size_t)t * ODD_INP + off, (hh == 16) ? kg : qg, CS64 + (size_t)t * 32, lane & 7);
                }
#pragma unroll
                for (int u2 = 0; u2 < 2; ++u2) hv_finish<64>(hr[u2], hhs[u2] <= 16, true, (hhs[u2] < 16) ? 0.125f * LOG2E : 1.0f, dsts[u2], lane & 7);
            }
            for (int e = gw * 64 + lane; e < T_ * 8; e += NGW * 64) {
                const int t = e >> 3, i = e & 7;
                WI[e] = bf2f(RA[(size_t)t * ODD_INP + 1728 + i]) * (0.35355339059327373f * 0.125f);
            }
            for (int it = gw; it < 8 * 32; it += NGW) {
                const int ch = it & 31, b = it >> 5;
                vt_item<1>(RA + (size_t)(b * S_ + ch * 64) * ODD_INP + 1088, ODD_INP, VTSP + ((size_t)b * 64 + lane) * 2048, ch * 64, 2048, lane);
            }
            } }
            GSYNC();
#ifndef SKIP_IDX
            { PH_VARS
            IDX_REP
            for (int ub = blockIdx.x; ub < 1024; ub += GRID_BLOCKS) {
                const int pass = ub >> 8, idx = ub & 255, b = idx & 7, i = idx >> 3;
                const int c16 = (pass == 0) ? 127 - i : (pass == 1) ? i : (pass == 2) ? 95 - i : 32 + i;
                const int t0 = c16 * 16 + wave * 2; const size_t tok0 = (size_t)b * S_ + t0;
                const int n = lane & 15, fq = lane >> 4, qs = fq >> 1, odd = fq & 1;
                bf16x8 qa[2];
#pragma unroll
                for (int kk = 0; kk < 2; ++kk) qa[kk] = *(const bf16x8*)(QI + ((tok0 + (n >> 3)) * 8 + (n & 7)) * 64 + kk * 32 + fq * 8);
                const f32x4 wv = *(const f32x4*)(WI + (tok0 + qs) * 8 + 4 * odd);
                const int tq = t0 + qs;
                constexpr int IKP = 144, ISTG = 256 * IKP;
                const int nstg = (c16 * 16 + 16 + 255) >> 8;
                const bf16_t* kib = KI + (size_t)b * S_ * 64;
                u32x4 stg[4];
#pragma unroll
                for (int q = 0; q < 4; ++q) stg[q] = *(const u32x4*)(kib + (size_t)(tid + q * 512) * 8);
#pragma unroll
                for (int q = 0; q < 4; ++q) { const int c = tid + q * 512; *(LAS u32x4*)(lds + (c >> 3) * IKP + (c & 7) * 16) = stg[q]; }
                __syncthreads();
                unsigned key[64];
#pragma unroll
                for (int sg = 0; sg < 8; ++sg) {
                    if (sg < nstg) {
                        const bool more = sg + 1 < nstg;
                        if (more) {
#pragma unroll
                            for (int q = 0; q < 4; ++q) stg[q] = *(const u32x4*)(kib + (size_t)(sg + 1) * 256 * 64 + (size_t)(tid + q * 512) * 8);
                        }
                        const LAS unsigned char* sb = lds + (sg & 1) * ISTG;
#pragma unroll
                        for (int j8 = 0; j8 < 8; ++j8) {
                            const int jj = sg * 8 + j8;
                            unsigned kv = 0u;
                            {
                                float sc2[2];
#pragma unroll
                                for (int tt = 0; tt < 2; ++tt) {
                                    const LAS unsigned char* kb = sb + ((2 * j8 + tt) * 16 + n) * IKP + fq * 16;
                                    f32x4 c4 = {0.f, 0.f, 0.f, 0.f};
                                    c4 = __builtin_amdgcn_mfma_f32_16x16x32_bf16(qa[0], *(const LAS bf16x8*)(kb), c4, 0, 0, 0);
                                    c4 = __builtin_amdgcn_mfma_f32_16x16x32_bf16(qa[1], *(const LAS bf16x8*)(kb + 64), c4, 0, 0, 0);
                                    float sc = wv[0] * fmaxf(c4[0], 0.f) + wv[1] * fmaxf(c4[1], 0.f) + wv[2] * fmaxf(c4[2], 0.f) + wv[3] * fmaxf(c4[3], 0.f);
                                    sc += __shfl_xor(sc, 16);
                                    sc2[tt] = sc;
                                }
                                float sc = odd ? sc2[1] : sc2[0];
                                if (sc == 0.f) sc = 0.f;
                                const unsigned ubits = __float_as_uint(sc);
                                kv = (ubits & 0x80000000u) ? ~ubits : (ubits | 0x80000000u);
                                if (32 * jj + 16 * odd + n > tq) kv = 0u;
                            }
                            key[jj] = kv;
                        }
                        if (more) {
                            LAS unsigned char* nb = lds + ((sg + 1) & 1) * ISTG;
#pragma unroll
                            for (int q = 0; q < 4; ++q) { const int c = tid + q * 512; *(LAS u32x4*)(nb + (c >> 3) * IKP + (c & 7) * 16) = stg[q]; }
                        }
                        __syncthreads();
                    } else {
#pragma unroll
                        for (int j8 = 0; j8 < 8; ++j8) key[sg * 8 + j8] = 0u;
                    }
                }
                LAS unsigned* wscr = (LAS unsigned*)(lds + 81920 + wave * 1024);
                unsigned tau = 0u;
                const bool all_valid = (tq + 1) <= 256;
                bool done_sel = all_valid;
#pragma unroll 1
                for (int bit = 31; bit >= 0; --bit) {
                    const unsigned cand = tau | (1u << bit);
                    int c0 = 0, c1 = 0;
#pragma unroll
                    for (int jj = 0; jj < 64; ++jj) { const unsigned long long bm = __ballot(key[jj] >= cand); c0 += __popc((unsigned)bm); c1 += __popc((unsigned)(bm >> 32)); }
                    const int cnt = (lane < 32) ? c0 : c1;
                    if (cnt >= 256) tau = cand;
                    done_sel = done_sel || (cnt == 256);
                    if (__ballot(!done_sel) == 0ull) break;
                }
                if (all_valid) tau = 1u;
                int g0 = 0, g1 = 0, e0 = 0, e1 = 0;
#pragma unroll
                for (int jj = 0; jj < 64; ++jj) {
                    const unsigned long long bg = __ballot(key[jj] > tau), be = __ballot(key[jj] == tau);
                    g0 += __popc((unsigned)bg); g1 += __popc((unsigned)(bg >> 32)); e0 += __popc((unsigned)be); e1 += __popc((unsigned)(be >> 32));
                }
                const int cgt = (lane < 32) ? g0 : g1, ceq = (lane < 32) ? e0 : e1;
                const int need_eq = all_valid ? (1 << 20) : 256 - cgt;
                const bool ties = (!all_valid) && (ceq > need_eq);
                unsigned w0 = 0u, w1 = 0u;
                if (__ballot(ties) == 0ull) {
#pragma unroll
                    for (int jj = 0; jj < 64; ++jj) {
                        const unsigned long long bm = __ballot(key[jj] >= tau);
                        if (lane == 0) { wscr[jj] = (unsigned)bm; wscr[64 + jj] = (unsigned)(bm >> 32); }
                    }
                } else {
                    int running = 0;
#pragma unroll
                    for (int jj = 0; jj < 64; ++jj) {
                        const bool e = key[jj] == tau;
                        const unsigned long long be = __ballot(e);
                        const unsigned hb = (unsigned)(be >> (32 * qs));
                        const int rank = running + __popc(hb & ((1u << (lane & 31)) - 1u));
                        running += __popc(hb);
                        const bool sel = (key[jj] > tau) || (e && rank < need_eq);
                        const unsigned long long bm = __ballot(sel);
                        if (lane == 0) { wscr[jj] = (unsigned)bm; wscr[64 + jj] = (unsigned)(bm >> 32); }
                    }
                }
                asm volatile("s_waitcnt lgkmcnt(0)" ::: "memory");
                w0 = wscr[lane]; w1 = wscr[64 + lane];
                MASKW[tok0 * 64 + lane] = w0; MASKW[(tok0 + 1) * 64 + lane] = w1;
                asm volatile("s_waitcnt lgkmcnt(0)" ::: "memory");
            }
            }
#endif
            GSYNC();
            { PH_VARS
            ATT_REP
            for (int ub = blockIdx.x; ub < 512; ub += GRID_BLOCKS) {
                const int pass = ub >> 8, idx = ub & 255, b = idx & 7, i = idx >> 3;
                const int qt = pass ? i : 63 - i, q0 = qt * 32, h = wave * 2;
                f32x16 o[2][2]; float mm[2], ll[2];
                attn_block<64, 64, 1, false, 64, 2>(lds, QSP + ((size_t)(b * S_ + q0) * 16 + h) * 64, 1024, 64, KSP + (size_t)b * S_ * 64, 64, VTSP + (size_t)b * 64 * 2048, 2048,
                                      qt + 1, qt + 1, q0, MASKW + (size_t)(b * S_ + q0) * 64, 0.f, o, mm, ll, tid);
                store_ot<64>(o[0], 1.0f / ll[0], MIX + (size_t)(b * S_ + q0 + r32) * 1024 + h * 64, hi);
                store_ot<64>(o[1], 1.0f / ll[1], MIX + (size_t)(b * S_ + q0 + r32) * 1024 + (h + 1) * 64, hi);
            }
            }
            GSYNC();
            { KA_DEF pg8::EpiResid E{X, X, XB, SSQ, 1.0f}; run_gemm(TIDX, lds, MIX, Wl + WO_WOUT, T_, 1024, 1024, E); }
            GSYNC();
        }
        { KA_DEF pg8::EpiBf16S E{RA, 1024, SSQ}; run_gemm(TIDX, lds, XB, Wl + WO_XQ, T_, 1024, 1024, E); }
        GSYNC();
        { PH_VARS
        ATT_REP
        for (int ub = blockIdx.x; ub < 512; ub += GRID_BLOCKS) {
            const int half = ub & 1, h = (ub >> 1) & 3, qblk = ub >> 3, b = qblk >> 3;
            const int tok0 = qblk * 256 + wave * 32;
            f32x16 o[1][4]; float mm[1], ll[1];
            const size_t kvb = (size_t)((l * 8 + b) * 4 + h) * 256;
            attn_block<256, 128, 2, true, 32, 1>(lds, RA + (size_t)tok0 * 1024 + h * 256, 1024, 0, KX + kvb * 256, 256, VTX + (kvb + half * 128) * 256, 256,
                                          8, 8, 0, nullptr, 0.0625f * LOG2E, o, mm, ll, tid);
            store_ot<128>(o[0], 1.0f / ll[0], OX + (size_t)(tok0 + r32) * 1024 + h * 256 + half * 128, hi);
        }
        }
        GSYNC();
        { KA_DEF pg8::EpiResid E{X, X, XB, SSQ, 1.0f}; run_gemm(TIDX, lds, OX, Wl + WO_XO, T_, 1024, 1024, E); }
        GSYNC();
        { KA_DEF pg8::EpiSwiGLU E{RA, FF, SSQ}; run_gemm(TIDX, lds, XB, Wl + WO_13B, T_, 2 * FF, 1024, E); }
        GSYNC();
        { KA_DEF pg8::EpiResid E{X, X, XB, SSQ, 0.5f}; run_gemm(TIDX, lds, RA, Wl + WO_2B, T_, 1024, FF, E); }
        if (l + 1 < NL) GSYNC();
    }
}

extern "C" void kernel_launch(void* const* d_in, const int* in_sizes, int n_in, void* d_out, int out_size, void* d_ws, size_t ws_size, hipStream_t stream) {
    static int grid = 0;
    if (grid == 0) {
        if (n_in != 31 || out_size != T_ * DM || ws_size < WS_END) { fprintf(stderr, "kernel_launch: unexpected shapes (n_in %d out %d ws %zu)\n", n_in, out_size, ws_size); grid = -1; return; }
        int dev = 0, cus = 0, per_cu = 0;
        hipGetDevice(&dev);
        hipDeviceGetAttribute(&cus, hipDeviceAttributeMultiprocessorCount, dev);
        if (hipFuncSetAttribute((const void*)mega_fwd, hipFuncAttributeMaxDynamicSharedMemorySize, LDS_BYTES) != hipSuccess) fprintf(stderr, "kernel_launch: hipFuncSetAttribute failed\n");
        if (hipOccupancyMaxActiveBlocksPerMultiprocessor(&per_cu, (const void*)mega_fwd, 512, LDS_BYTES) != hipSuccess || per_cu < 1) { fprintf(stderr, "kernel_launch: occupancy query says %d\n", per_cu); per_cu = 1; }
        (void)hipGetLastError();
        if (cus * per_cu < GRID_BLOCKS) fprintf(stderr, "kernel_launch: device holds %d co-resident workgroups, kernel is built for %d\n", cus * per_cu, GRID_BLOCKS);
        grid = GRID_BLOCKS;
    }
    if (grid < 0) return;
    if (hipMemsetAsync((char*)d_ws + WS_CTL, 0, 16384, stream) != hipSuccess) { fprintf(stderr, "kernel_launch: memset failed\n"); return; }
    KArgs a{};
    for (int i = 0; i < 31; ++i) a.in[i] = d_in[i];
    a.out = (float*)d_out; a.ws = (unsigned char*)d_ws;
    void* args[] = {&a};
    hipError_t e = hipLaunchCooperativeKernel((const void*)mega_fwd, dim3(grid), dim3(512), args, LDS_BYTES, stream);
    if (e != hipSuccess) fprintf(stderr, "kernel_launch: cooperative launch failed: %s (grid %d)\n", hipGetErrorString(e), grid);
}
```

```cpp
#include <hip/hip_runtime.h>
#include <hip/hip_cooperative_groups.h>
#include <cstdio>
#include <cstdint>
namespace cg = cooperative_groups;
namespace pg8 {
#define PG8_LAS __attribute__((address_space(3)))
typedef unsigned short bf16_t;
typedef short bf16x8 __attribute__((ext_vector_type(8)));
typedef float f32x4 __attribute__((ext_vector_type(4)));
typedef unsigned u32x4 __attribute__((ext_vector_type(4)));
constexpr int BM = 256, BK = 64, HALF = 128, HTB = HALF * BK * 2  , STAGE_BYTES = 8 * HTB, NXCD = 8, WGM = 8;

__host__ __device__ __forceinline__ int lds_byte(int r, int c) { const int st = (r >> 4) * 2 + (c >> 5), rr = r & 15, cc = c & 31, ob = rr * 64 + cc * 2; return st * 1024 + (ob ^ (((ob >> 9) & 1) << 5)); }
__host__ __device__ __forceinline__ void stage_rc(int b, int& R, int& C) { const int st = b / 1024, sb = b % 1024, swz = sb ^ (((sb >> 9) & 1) << 5); R = (st >> 1) * 16 + swz / 64; C = (st & 1) * 32 + (swz % 64) / 2; }
__host__ __device__ __forceinline__ int perm32(int rho) { const int n = rho >> 4, i = rho & 15; return 8 * (i >> 2) + 4 * n + (i & 3); }

struct Unit { int pm, pn; };
struct Gemm { const bf16_t* A; const bf16_t* Bt; int M, N, K, tid; };

struct StaticOrder {
    int nM, nN, nwg, G, c;
    __host__ __device__ void init(int M, int N, int G_, int c_) { nM = M / BM; nN = N / BM; nwg = nM * nN; G = G_; c = c_; }
    __host__ __device__ bool next(int i, Unit& u) const {
        const long L = (long)i * G + c; if (L >= nwg) return false;
        int wgid = (int)L; { const int q = nwg / NXCD, r = nwg % NXCD, xcd = wgid % NXCD, off = wgid / NXCD; wgid = (xcd < r ? xcd * (q + 1) : r * (q + 1) + (xcd - r) * q) + off; }
        const int nig = WGM * nN, gid = wgid / nig, fm = gid * WGM, gsz = (nM - fm) < WGM ? (nM - fm) : WGM;
        u.pm = fm + ((wgid % nig) % gsz); u.pn = (wgid % nig) / gsz; return true;
    }
    __device__ __forceinline__ void a_ready(const Unit&) const {}
    __device__ __forceinline__ void done(const Unit&) const {}
};

__device__ __forceinline__ unsigned cvt_pk_bf16(float lo, float hi) { unsigned r; asm volatile("v_cvt_pk_bf16_f32 %0, %1, %2" : "=v"(r) : "v"(lo), "v"(hi)); return r; }
template <class Epi, class Sched, bool ALIGN_EPI = false, bool SP2 = false>
__device__ __forceinline__ void gemm_phase(PG8_LAS unsigned char* lds, const Gemm g, const Sched& S, const Epi& E) {
    int tid_ = g.tid; asm volatile("" : "+v"(tid_));
    const int tid = tid_, wid = __builtin_amdgcn_readfirstlane(tid >> 6), lane = tid & 63, wr = wid >> 2, wc = wid & 3, fr = lane & 15, fq = lane >> 4;
    const int K = g.K, nt = K / BK;
    unsigned voffA[2], voffB[2];
#pragma unroll
    for (int i = 0; i < 2; ++i) { int R, C; stage_rc(tid * 16 + i * 8192, R, C); const int Rb = Epi::PERM ? ((R & ~31) + perm32(R & 31)) : R;
        voffA[i] = (unsigned)(R * K + C) * 2u; voffB[i] = (unsigned)(Rb * K + C) * 2u; }
    const size_t kstep = (size_t)(BK * 2);
    const size_t hstep = (size_t)HALF * K * 2;
    const size_t tstep = 2 * hstep;
    const unsigned ldsw = (unsigned)wid * 1024u;
    const int aoff = lds_byte(wr * 64 + fr, fq * 8), boff = lds_byte(wc * 32 + fr, fq * 8);
#define PG8_SA(b, h) (((b) * 2 + (h)) * HTB)
#define PG8_SB(b, h) ((4 + (b) * 2 + (h)) * HTB)
#define PG8_STAGE(bufoff, gbase, voff) do { _Pragma("unroll") for (int _i = 0; _i < 2; ++_i) \
        __builtin_amdgcn_global_load_lds((const unsigned*)((const char*)(gbase) + (voff)[_i]), (PG8_LAS unsigned*)(lds + (bufoff) + ldsw + _i * 8192), 16, 0, 0); } while (0)
#define PG8_LDA(dst, b, h) do { _Pragma("unroll") for (int m = 0; m < 4; ++m) _Pragma("unroll") for (int k = 0; k < 2; ++k) dst[m][k] = *(const PG8_LAS bf16x8*)(lds + PG8_SA(b, h) + aoff + m * 2048 + k * 1024); } while (0)
#define PG8_LDB(dst, b, h) do { _Pragma("unroll") for (int n = 0; n < 2; ++n) _Pragma("unroll") for (int k = 0; k < 2; ++k) dst[n][k] = *(const PG8_LAS bf16x8*)(lds + PG8_SB(b, h) + boff + n * 2048 + k * 1024); } while (0)
#define PG8_MMA(ai, bj, At, Bt) do { __builtin_amdgcn_s_setprio(1); _Pragma("unroll") for (int m = 0; m < 4; ++m) _Pragma("unroll") for (int n = 0; n < 2; ++n) _Pragma("unroll") for (int k = 0; k < 2; ++k) \
        acc[ai][bj][m][n] = __builtin_amdgcn_mfma_f32_16x16x32_bf16(Bt[n][k], At[m][k], acc[ai][bj][m][n], 0, 0, 0); __builtin_amdgcn_s_setprio(0); } while (0)
#define PG8_WAIT_V(n) asm volatile("s_waitcnt vmcnt(" #n ")" ::: "memory")
#define PG8_WAIT_L(n) asm volatile("s_waitcnt lgkmcnt(" #n ")" ::: "memory")
#define PG8_BAR __builtin_amdgcn_s_barrier()
#define PG8_SCHED __builtin_amdgcn_sched_barrier(0)
    Unit cur, nxt; int ui = 0;
    if (!S.next(0, cur)) return;
    f32x4 acc[2][2][4][2];
#pragma unroll
    for (int a = 0; a < 2; ++a)
#pragma unroll
        for (int b = 0; b < 2; ++b)
#pragma unroll
            for (int m = 0; m < 4; ++m)
#pragma unroll
                for (int n = 0; n < 2; ++n) acc[a][b][m][n] = (f32x4){0.f, 0.f, 0.f, 0.f};
    bf16x8 At[4][2], B0[2][2], B1[2][2];
    const char* cA = (const char*)g.A + (size_t)cur.pm * tstep; const char* cB = (const char*)g.Bt + (size_t)cur.pn * tstep;
    S.a_ready(cur);
    if constexpr (SP2) {
        PG8_STAGE(PG8_SB(0, 0), cB, voffB); PG8_STAGE(PG8_SB(0, 1), cB + hstep, voffB); PG8_STAGE(PG8_SA(0, 0), cA, voffA); PG8_STAGE(PG8_SA(0, 1), cA + hstep, voffA);
        if (wr == 1) PG8_BAR;
        PG8_WAIT_V(2); PG8_BAR;
        PG8_STAGE(PG8_SB(1, 0), cB + kstep, voffB); PG8_STAGE(PG8_SA(1, 0), cA + kstep, voffA); PG8_STAGE(PG8_SB(1, 1), cB + hstep + kstep, voffB);
        PG8_WAIT_V(6); PG8_BAR;
    } else {
        PG8_STAGE(PG8_SB(0, 0), cB, voffB); PG8_STAGE(PG8_SA(0, 0), cA, voffA); PG8_STAGE(PG8_SB(0, 1), cB + hstep, voffB); PG8_STAGE(PG8_SA(0, 1), cA + hstep, voffA);
        if (wr == 1) PG8_BAR;
        PG8_WAIT_V(4); PG8_BAR;
        PG8_STAGE(PG8_SB(1, 0), cB + kstep, voffB); PG8_STAGE(PG8_SA(1, 0), cA + kstep, voffA); PG8_STAGE(PG8_SB(1, 1), cB + hstep + kstep, voffB);
        PG8_WAIT_V(6); PG8_BAR;
    }
    for (;;) {
        const bool has_next = S.next(ui + 1, nxt);
        const char* nA = has_next ? (const char*)g.A + (size_t)nxt.pm * tstep : cA; const char* nB = has_next ? (const char*)g.Bt + (size_t)nxt.pn * tstep : cB;
        for (int t = 0; t < nt; t += 2) {
            const bool last = (t == nt - 2);
            const char* a1 = cA + (size_t)(t + 1) * kstep;
            const char* a2 = last ? nA : cA + (size_t)(t + 2) * kstep; const char* b2 = last ? nB : cB + (size_t)(t + 2) * kstep;
            const char* a3 = a2 + kstep; const char* b3 = b2 + kstep;
            if (last && has_next) S.a_ready(nxt);
            if constexpr (SP2) {
            PG8_LDB(B0, 0, 0); PG8_LDB(B1, 0, 1); PG8_SCHED; PG8_LDA(At, 0, 0); PG8_STAGE(PG8_SA(1, 1), a1 + hstep, voffA);
            PG8_WAIT_V(8); PG8_WAIT_L(0); PG8_BAR; PG8_MMA(0, 0, At, B0); PG8_MMA(0, 1, At, B1); PG8_BAR; PG8_SCHED;
            PG8_LDA(At, 0, 1); PG8_STAGE(PG8_SB(0, 0), b2, voffB); PG8_STAGE(PG8_SB(0, 1), b2 + hstep, voffB); PG8_STAGE(PG8_SA(0, 0), a2, voffA);
            PG8_WAIT_V(8); PG8_WAIT_L(0); PG8_BAR; PG8_MMA(1, 0, At, B0); PG8_MMA(1, 1, At, B1); PG8_BAR; PG8_SCHED;
            PG8_LDB(B0, 1, 0); PG8_LDB(B1, 1, 1); PG8_SCHED; PG8_LDA(At, 1, 0); PG8_STAGE(PG8_SA(0, 1), a2 + hstep, voffA);
            PG8_WAIT_V(8); PG8_WAIT_L(0); PG8_BAR; PG8_MMA(0, 0, At, B0); PG8_MMA(0, 1, At, B1); PG8_BAR; PG8_SCHED;
            PG8_LDA(At, 1, 1); PG8_STAGE(PG8_SB(1, 0), b3, voffB); PG8_STAGE(PG8_SB(1, 1), b3 + hstep, voffB); PG8_STAGE(PG8_SA(1, 0), a3, voffA);
            PG8_WAIT_V(8); PG8_WAIT_L(0); PG8_BAR; PG8_MMA(1, 0, At, B0); PG8_MMA(1, 1, At, B1); PG8_BAR; PG8_SCHED;
            } else {
            PG8_LDB(B0, 0, 0); PG8_SCHED; PG8_LDA(At, 0, 0); PG8_STAGE(PG8_SA(1, 1), a1 + hstep, voffA);
            PG8_WAIT_L(8); PG8_BAR; PG8_WAIT_L(0); PG8_MMA(0, 0, At, B0); PG8_BAR; PG8_SCHED;
            PG8_LDB(B1, 0, 1); PG8_STAGE(PG8_SB(0, 0), b2, voffB);
            PG8_BAR; PG8_WAIT_L(0); PG8_MMA(0, 1, At, B1); PG8_BAR;
            PG8_LDA(At, 0, 1); PG8_STAGE(PG8_SA(0, 0), a2, voffA);
            PG8_BAR; PG8_WAIT_L(0); PG8_MMA(1, 0, At, B0); PG8_BAR; PG8_SCHED;
            PG8_STAGE(PG8_SB(0, 1), b2 + hstep, voffB);
            PG8_WAIT_V(6); PG8_BAR; PG8_MMA(1, 1, At, B1); PG8_BAR;
            PG8_LDB(B0, 1, 0); PG8_SCHED; PG8_LDA(At, 1, 0); PG8_STAGE(PG8_SA(0, 1), a2 + hstep, voffA);
            PG8_WAIT_L(8); PG8_BAR; PG8_WAIT_L(0); PG8_MMA(0, 0, At, B0); PG8_BAR; PG8_SCHED;
            PG8_LDB(B1, 1, 1); PG8_STAGE(PG8_SB(1, 0), b3, voffB);
            PG8_BAR; PG8_WAIT_L(0); PG8_MMA(0, 1, At, B1); PG8_BAR;
            PG8_LDA(At, 1, 1); PG8_STAGE(PG8_SA(1, 0), a3, voffA);
            PG8_BAR; PG8_WAIT_L(0); PG8_MMA(1, 0, At, B0); PG8_BAR; PG8_SCHED;
            PG8_STAGE(PG8_SB(1, 1), b3 + hstep, voffB);
            PG8_WAIT_V(6); PG8_BAR; PG8_MMA(1, 1, At, B1); PG8_BAR;
            }
        }
        if constexpr (ALIGN_EPI) { if (wr == 0) PG8_BAR; }
        if constexpr (!Epi::AFTER_DRAIN) { E(acc, cur, wr, wc, fr, fq); S.done(cur); }
        if (!has_next) break;
#pragma unroll
        for (int a = 0; a < 2; ++a)
#pragma unroll
            for (int b = 0; b < 2; ++b)
#pragma unroll
                for (int m = 0; m < 4; ++m)
#pragma unroll
                    for (int n = 0; n < 2; ++n) acc[a][b][m][n] = (f32x4){0.f, 0.f, 0.f, 0.f};
        cur = nxt; cA = nA; cB = nB; ++ui;
        if constexpr (ALIGN_EPI) { if (wr == 1) PG8_BAR; }
    }
    PG8_WAIT_V(0);
    if constexpr (!ALIGN_EPI) { if (wr == 0) PG8_BAR; }
    PG8_BAR;
    if constexpr (Epi::AFTER_DRAIN) { E.fused(acc, cur, wr, wc, fr, fq, lds, wid, lane); S.done(cur); }
#undef PG8_SA
#undef PG8_SB
#undef PG8_STAGE
#undef PG8_LDA
#undef PG8_LDB
#undef PG8_MMA
#undef PG8_WAIT_V
#undef PG8_WAIT_L
#undef PG8_BAR
#undef PG8_SCHED
}
}

#define LAS __attribute__((address_space(3)))
typedef unsigned short bf16_t;
typedef short bf16x8 __attribute__((ext_vector_type(8)));
typedef float f32x4 __attribute__((ext_vector_type(4)));
typedef float f32x16 __attribute__((ext_vector_type(16)));
typedef unsigned u32x4 __attribute__((ext_vector_type(4)));
typedef unsigned u32x2 __attribute__((ext_vector_type(2)));
typedef float f32x2 __attribute__((ext_vector_type(2)));

constexpr int T_ = 16384, S_ = 2048, NBATCH = 8, DM = 1024, FF = 2816, MEMLEN = 256, NL = 4;
constexpr int EVEN_IN = 2720, EVEN_INP = 2816, ODD_IN = 1736, ODD_INP = 1792;
constexpr float EPS = 1e-6f, LOG2E = 1.4426950408889634f;
constexpr int LDS_BYTES = 147456;
constexpr int BIGW = 1 << 30;
constexpr int GRID_BLOCKS = 256;

constexpr size_t MiB = 1u << 20;
constexpr size_t WS_W = 0, WS_XKV = 48 * MiB, WS_KX = 64 * MiB, WS_VTX = 80 * MiB, WS_XB = 96 * MiB, WS_SSQ = 128 * MiB, WS_MEMB = 129 * MiB,
                 WS_MEMSSQ = 133 * MiB, WS_CS64 = 134 * MiB, WS_CS32 = 138 * MiB, WS_A = 140 * MiB, WS_B = 228 * MiB, WS_CTL = 377 * MiB, WS_END = 378 * MiB;
constexpr size_t WO_13A = 0, WO_2A = WO_13A + (size_t)5632 * 1024, WO_13B = WO_2A + (size_t)1024 * 2816, WO_2B = WO_13B + (size_t)5632 * 1024,
                 WO_XQ = WO_2B + (size_t)1024 * 2816, WO_XO = WO_XQ + (size_t)1024 * 1024, WO_WIN = WO_XO + (size_t)1024 * 1024,
                 WO_BD = WO_WIN + (size_t)2816 * 1024, WO_WOUT = WO_BD + (size_t)1792 * 384, WO_END = WO_WOUT + (size_t)1024 * 1024;
static_assert(WO_END * 2 <= 48 * MiB, "weights region");
constexpr size_t B_QD = 0, B_KD = 24 * MiB, B_VTD = 48 * MiB, B_QM = 72 * MiB, B_KM = 96 * MiB, B_VTM = 120 * MiB, B_CQKV = 136 * MiB, B_KROPE = 148 * MiB;
constexpr size_t B_QSP = 0, B_QI = 32 * MiB, B_KSP = 48 * MiB, B_VTSP = 50 * MiB, B_KI = 52 * MiB, B_WI = 54 * MiB, B_MASKW = 55 * MiB;
constexpr size_t B_KVRAW = 0;
constexpr size_t A_MIX = 0, A_ODIL = 24 * MiB, A_LSE = 48 * MiB, A_OX = 32 * MiB;

__device__ __forceinline__ unsigned f2bf(float f) { unsigned u = __float_as_uint(f); return (u + 0x7fffu + ((u >> 16) & 1u)) >> 16; }
__device__ __forceinline__ float bf2f(unsigned h) { return __uint_as_float(h << 16); }
__device__ __forceinline__ unsigned pk2(float lo, float hi) { return f2bf(lo) | (f2bf(hi) << 16); }
__device__ __forceinline__ float wave_sum(float v) {
#pragma unroll
    for (int o = 1; o < 64; o <<= 1) v += __shfl_xor(v, o);
    return v;
}
template <int N> __device__ __forceinline__ void wave_sum_n(float (&v)[N]) {
#pragma unroll
    for (int o = 1; o < 64; o <<= 1) {
#pragma unroll
        for (int i = 0; i < N; ++i) v[i] += __shfl_xor(v[i], o);
    }
}
__device__ __forceinline__ float row_rstd16(const float* ssq, int row, float inv_n) {
    const f32x4* p = (const f32x4*)(ssq + (size_t)row * 16);
    const f32x4 a = p[0], b = p[1], c = p[2], d = p[3];
    const float s = ((a[0] + a[1]) + (a[2] + a[3])) + ((b[0] + b[1]) + (b[2] + b[3])) + ((c[0] + c[1]) + (c[2] + c[3])) + ((d[0] + d[1]) + (d[2] + d[3]));
    return __builtin_amdgcn_rsqf(s * inv_n + EPS);
}

__device__ __forceinline__ float row_rstd16_coop(const float* ssq, int row, int fq, float inv_n) {
    const f32x4 a = *(const f32x4*)(ssq + (size_t)row * 16 + fq * 4);
    float s = (a[0] + a[1]) + (a[2] + a[3]);
    s += __shfl_xor(s, 16); s += __shfl_xor(s, 32);
    return __builtin_amdgcn_rsqf(s * inv_n + EPS);
}
namespace pg8 {
struct EpiBf16S {
    static constexpr bool PERM = true, AFTER_DRAIN = false; static constexpr int EID = 0;
    bf16_t* O; int ldc; const float* ssq;
    __device__ __forceinline__ void operator()(const f32x4 (&acc)[2][2][4][2], const Unit& u, int wr, int wc, int fr, int fq) const {
        const int row0 = u.pm * BM + wr * 64 + fr, col0 = u.pn * BM + wc * 32 + 8 * fq;
        float rsv[2][4];
#pragma unroll
        for (int ai = 0; ai < 2; ++ai) {
#pragma unroll
            for (int m = 0; m < 4; ++m) rsv[ai][m] = ssq ? row_rstd16_coop(ssq, row0 + ai * HALF + m * 16, fq, 1.0f / 1024.0f) : 1.0f;
        }
#pragma unroll
        for (int ai = 0; ai < 2; ++ai)
#pragma unroll
            for (int m = 0; m < 4; ++m) {
                const int row = row0 + ai * HALF + m * 16;
                const float rs = rsv[ai][m];
                bf16_t* rowp = O + (size_t)row * ldc + col0;
#pragma unroll
                for (int bj = 0; bj < 2; ++bj) {
                    const f32x4 v0 = acc[ai][bj][m][0] * rs, v1 = acc[ai][bj][m][1] * rs;
                    u32x4 w; w.x = cvt_pk_bf16(v0[0], v0[1]); w.y = cvt_pk_bf16(v0[2], v0[3]); w.z = cvt_pk_bf16(v1[0], v1[1]); w.w = cvt_pk_bf16(v1[2], v1[3]);
                    *(u32x4*)(rowp + bj * HALF) = w;
                }
            }
    }
};
struct EpiSwiGLU {
    static constexpr bool PERM = true, AFTER_DRAIN = false; static constexpr int EID = 1;
    bf16_t* H; int ldh; const float* ssq;
    __device__ __forceinline__ static float sg(float g, float uu) { return g * __builtin_amdgcn_rcpf(1.0f + __builtin_amdgcn_exp2f(-1.4426950408889634f * g)) * uu; }
    __device__ __forceinline__ void operator()(const f32x4 (&acc)[2][2][4][2], const Unit& u, int wr, int wc, int fr, int fq) const {
        const int row0 = u.pm * BM + wr * 64 + fr, col0 = u.pn * BM + wc * 32 + 8 * fq;
        float rsv[2][4];
#pragma unroll
        for (int ai = 0; ai < 2; ++ai) {
#pragma unroll
            for (int m = 0; m < 4; ++m) rsv[ai][m] = row_rstd16_coop(ssq, row0 + ai * HALF + m * 16, fq, 1.0f / 1024.0f);
        }
#pragma unroll
        for (int ai = 0; ai < 2; ++ai)
#pragma unroll
            for (int m = 0; m < 4; ++m) {
                const int row = row0 + ai * HALF + m * 16;
                const float rs = rsv[ai][m];
                bf16_t* rowp = H + (size_t)row * ldh + (col0 >> 1);
#pragma unroll
                for (int bj = 0; bj < 2; ++bj) {
                    const f32x4 v0 = acc[ai][bj][m][0] * rs, v1 = acc[ai][bj][m][1] * rs;
                    u32x2 w; w.x = cvt_pk_bf16(sg(v0[0], v0[1]), sg(v0[2], v0[3])); w.y = cvt_pk_bf16(sg(v1[0], v1[1]), sg(v1[2], v1[3]));
                    *(u32x2*)(rowp + bj * (HALF / 2)) = w;
                }
            }
    }
};
struct EpiResid {
    static constexpr bool PERM = true, AFTER_DRAIN = false; static constexpr int EID = 2;
    const float* Xin; float* X; bf16_t* XB; float* ssq; float scale;
    __device__ __forceinline__ void operator()(const f32x4 (&acc)[2][2][4][2], const Unit& u, int wr, int wc, int fr, int fq) const {
        const int row0 = u.pm * BM + wr * 64 + fr, col0 = u.pn * BM + wc * 32 + 8 * fq;
        f32x4 xv[2][2][2][2];
#define RESID_LOAD(buf, g) do { _Pragma("unroll") for (int rr_ = 0; rr_ < 2; ++rr_) { const int idx_ = 2 * (g) + rr_; const int row_ = row0 + (idx_ >> 2) * HALF + (idx_ & 3) * 16; \
            _Pragma("unroll") for (int bj_ = 0; bj_ < 2; ++bj_) { const f32x4* p_ = (const f32x4*)(Xin + (size_t)row_ * 1024 + col0 + bj_ * HALF); xv[buf][rr_][bj_][0] = p_[0]; xv[buf][rr_][bj_][1] = p_[1]; } } } while (0)
        RESID_LOAD(0, 0);
#pragma unroll
        for (int g = 0; g < 4; ++g) {
            if (g < 3) RESID_LOAD((g + 1) & 1, g + 1);
#pragma unroll
            for (int rr = 0; rr < 2; ++rr) {
                const int idx = 2 * g + rr, ai = idx >> 2, m = idx & 3;
                const int row = row0 + ai * HALF + m * 16;
                float* xr = X + (size_t)row * 1024 + col0; bf16_t* br = XB + (size_t)row * 1024 + col0;
                float ss = 0.f;
#pragma unroll
                for (int bj = 0; bj < 2; ++bj) {
                    f32x4* p = (f32x4*)(xr + bj * HALF);
                    const f32x4 o0 = xv[g & 1][rr][bj][0] + acc[ai][bj][m][0] * scale, o1 = xv[g & 1][rr][bj][1] + acc[ai][bj][m][1] * scale;
                    p[0] = o0; p[1] = o1;
                    u32x4 w; w.x = cvt_pk_bf16(o0[0], o0[1]); w.y = cvt_pk_bf16(o0[2], o0[3]); w.z = cvt_pk_bf16(o1[0], o1[1]); w.w = cvt_pk_bf16(o1[2], o1[3]);
                    *(u32x4*)(br + bj * HALF) = w;
                    ss += (o0[0] * o0[0] + o0[1] * o0[1]) + (o0[2] * o0[2] + o0[3] * o0[3]) + (o1[0] * o1[0] + o1[1] * o1[1]) + (o1[2] * o1[2] + o1[3] * o1[3]);
                }
                ss += __shfl_xor(ss, 16); ss += __shfl_xor(ss, 32);
                if (fq == 0) ssq[(size_t)row * 16 + u.pn * 4 + wc] = ss;
            }
            asm volatile("" ::: "memory");
        }
#undef RESID_LOAD
    }
};
}

template <class Epi> __device__ __forceinline__ void run_gemm(const int tid, LAS unsigned char* lds, const bf16_t* A, const bf16_t* Bt, int M, int N, int K, const Epi& E) {
    asm volatile("" : "+s"(M), "+s"(N), "+s"(K)); asm volatile("" : "+s"(A), "+s"(Bt));
    pg8::Gemm g{A, Bt, M, N, K, tid}; pg8::StaticOrder S; S.init(M, N, (int)gridDim.x, (int)blockIdx.x);
#ifndef SKIP_GEMM
#ifdef REP_GEMM
    { Epi E0 = E; if constexpr (Epi::EID == 2) E0.scale = 0.f; pg8::gemm_phase<Epi, pg8::StaticOrder, true, true>(lds, g, S, E0); }
#endif
    pg8::gemm_phase<Epi, pg8::StaticOrder, true, (Epi::EID != 2)>(lds, g, S, E);
#endif
}

__device__ __forceinline__ void conv_item(const float* __restrict__ W, const float* __restrict__ g, int K, int NS, int NP, bf16_t* __restrict__ dst, int ldd, int koff, int row_off, int ilv,
                                          LAS float* scr, int item, int lane) {
    (void)K;
    LAS unsigned char* tile = (LAS unsigned char*)scr;
    const int nblk = (NP + 127) / 128, kb = item / nblk, nb = item % nblk, k0 = 64 * kb, n0 = 128 * nb, n = n0 + lane * 2;
    const bool rd = (W != nullptr) && (n < NS);
#pragma unroll 1
    for (int b2 = 0; b2 < 2; ++b2) {
        f32x2 v[32];
#pragma unroll
        for (int r = 0; r < 32; ++r) {
            const int k = k0 + b2 * 32 + r;
            v[r] = rd ? __builtin_nontemporal_load((const f32x2*)(W + (size_t)k * NS + n)) : (f32x2){0.f, 0.f};
        }
        if (g != nullptr) {
#pragma unroll
            for (int r = 0; r < 32; ++r) v[r] = v[r] * g[k0 + b2 * 32 + r];
        }
#pragma unroll
        for (int i = 0; i < 2; ++i) {
            const int nl = lane * 2 + i;
#pragma unroll
            for (int h = 0; h < 4; ++h) {
                u32x4 o; o.x = pk2(v[h * 8 + 0][i], v[h * 8 + 1][i]); o.y = pk2(v[h * 8 + 2][i], v[h * 8 + 3][i]); o.z = pk2(v[h * 8 + 4][i], v[h * 8 + 5][i]); o.w = pk2(v[h * 8 + 6][i], v[h * 8 + 7][i]);
                *(LAS u32x4*)(tile + nl * 128 + (((b2 * 4 + h) ^ (lane & 7)) << 4)) = o;
            }
        }
    }
    asm volatile("s_waitcnt lgkmcnt(0)" ::: "memory");
#pragma unroll
    for (int j = 0; j < 16; ++j) {
        const int idx = j * 64 + lane, nl = idx >> 3, q = idx & 7, nn = n0 + nl;
        const u32x4 o = *(const LAS u32x4*)(tile + nl * 128 + ((q ^ ((nl >> 1) & 7)) << 4));
        if (nn < NP) {
            const int drow = row_off + (ilv ? (nn < ilv ? 2 * nn : 2 * (nn - ilv) + 1) : nn);
            *(u32x4*)(dst + (size_t)drow * ldd + koff + k0 + q * 8) = o;
        }
    }
    asm volatile("s_waitcnt lgkmcnt(0)" ::: "memory");
}

__device__ __forceinline__ int crow(int r, int hi) { return (r & 3) + 8 * (r >> 2) + 4 * hi; }

template <int DQK, int DV, int MODE, bool QNORM, bool PF>
__device__ __forceinline__ void attn_tile(const bf16_t* __restrict__ Qp, int q_pitch, const bf16_t* __restrict__ Kp, int k_pitch,
                                          const bf16_t* __restrict__ Vt, int vt_pitch, int kt_lo, int kt_hi, int q0, int qoff, int W,
                                          const unsigned* __restrict__ mw, float qk_scale, f32x16 (&o)[DV / 32], float& m_out, float& l_out, const int lane) {
    const int r32 = lane & 31, hi = lane >> 5;
    bf16x8 qf[DQK / 16];
#pragma unroll
    for (int d0 = 0; d0 < DQK / 16; ++d0) qf[d0] = *(const bf16x8*)(Qp + (size_t)r32 * q_pitch + d0 * 16 + hi * 8);
    float sscale = 1.0f;
    if (QNORM) {
        float ss = 0.f;
#pragma unroll
        for (int d0 = 0; d0 < DQK / 16; ++d0)
#pragma unroll
            for (int j = 0; j < 8; ++j) { const float v = bf2f((unsigned)(unsigned short)qf[d0][j]); ss += v * v; }
        ss += __shfl_xor(ss, 32);
        sscale = qk_scale * __builtin_amdgcn_rsqf(ss * (1.0f / DQK) + EPS);
    }
    float m_run = 0.f, l_run = 0.f;
#pragma unroll
    for (int dt = 0; dt < DV / 32; ++dt)
#pragma unroll
        for (int r = 0; r < 16; ++r) o[dt][r] = 0.f;
    const bf16_t* kbase = Kp + (size_t)r32 * k_pitch + hi * 8;
    const bf16_t* vbase = Vt + (size_t)r32 * vt_pitch + hi * 8;
    const unsigned* mbase = (MODE == 1) ? (mw + (size_t)r32 * 64) : nullptr;
    bf16x8 kf[DQK / 16], vf[DV / 32][2]; unsigned w = 0xffffffffu;
#define ATT_LOAD(KF, VF, WW, kt_) do { const bf16_t* kb_ = kbase + (size_t)(kt_) * 32 * k_pitch; \
        _Pragma("unroll") for (int d0 = 0; d0 < DQK / 16; ++d0) KF[d0] = *(const bf16x8*)(kb_ + d0 * 16); \
        _Pragma("unroll") for (int dt = 0; dt < DV / 32; ++dt) _Pragma("unroll") for (int ks = 0; ks < 2; ++ks) VF[dt][ks] = *(const bf16x8*)(vbase + (size_t)dt * 32 * vt_pitch + (kt_) * 32 + ks * 16); \
        if (MODE == 1) WW = mbase[kt_]; } while (0)
    if (PF) { if (kt_lo < kt_hi) ATT_LOAD(kf, vf, w, kt_lo); }
    for (int kt = kt_lo; kt < kt_hi; ++kt) {
        bf16x8 kfn[PF ? DQK / 16 : 1], vfn[PF ? DV / 32 : 1][2]; unsigned wn = 0xffffffffu;
        if (PF) { if (kt + 1 < kt_hi) ATT_LOAD(kfn, vfn, wn, kt + 1); }
        else ATT_LOAD(kf, vf, w, kt);
        f32x16 s;
#pragma unroll
        for (int r = 0; r < 16; ++r) s[r] = 0.f;
#pragma unroll
        for (int d0 = 0; d0 < DQK / 16; ++d0) s = __builtin_amdgcn_mfma_f32_32x32x16_bf16(kf[d0], qf[d0], s, 0, 0, 0);
#pragma unroll
        for (int r = 0; r < 16; ++r) s[r] = QNORM ? (s[r] * sscale - m_run) : (s[r] - m_run);
        if (MODE == 0) {
            const int dmax = q0 + 31 + qoff - kt * 32, dmin = q0 + qoff - kt * 32 - 31;
            if (!(dmin >= 0 && dmax <= W)) {
#pragma unroll
                for (int r = 0; r < 16; ++r) { const int d = q0 + r32 + qoff - (kt * 32 + crow(r, hi)); if ((unsigned)d > (unsigned)W) s[r] = -INFINITY; }
            }
        } else {
#pragma unroll
            for (int r = 0; r < 16; ++r) { if (((w >> crow(r, hi)) & 1u) == 0u) s[r] = -INFINITY; }
        }
        float tm = s[0];
#pragma unroll
        for (int r = 1; r < 16; ++r) tm = fmaxf(tm, s[r]);
        tm = fmaxf(tm, __shfl_xor(tm, 32));
        if (__ballot(tm > 0.f) != 0ull) {
            const float dl = fmaxf(tm, 0.f); m_run += dl;
            const float alpha = __builtin_amdgcn_exp2f(-dl);
            l_run *= alpha;
#pragma unroll
            for (int r = 0; r < 16; ++r) s[r] -= dl;
#pragma unroll
            for (int dt = 0; dt < DV / 32; ++dt)
#pragma unroll
                for (int r = 0; r < 16; ++r) o[dt][r] *= alpha;
        }
        float ps = 0.f;
#pragma unroll
        for (int r = 0; r < 16; ++r) { s[r] = __builtin_amdgcn_exp2f(s[r]); ps += s[r]; }
        l_run += ps;
        u32x4 p0, p1;
        p0.x = pg8::cvt_pk_bf16(s[0], s[1]); p0.y = pg8::cvt_pk_bf16(s[2], s[3]); p0.z = pg8::cvt_pk_bf16(s[4], s[5]); p0.w = pg8::cvt_pk_bf16(s[6], s[7]);
        p1.x = pg8::cvt_pk_bf16(s[8], s[9]); p1.y = pg8::cvt_pk_bf16(s[10], s[11]); p1.z = pg8::cvt_pk_bf16(s[12], s[13]); p1.w = pg8::cvt_pk_bf16(s[14], s[15]);
        const bf16x8 pf0 = __builtin_bit_cast(bf16x8, p0), pf1 = __builtin_bit_cast(bf16x8, p1);
#pragma unroll
        for (int dt = 0; dt < DV / 32; ++dt) {
            o[dt] = __builtin_amdgcn_mfma_f32_32x32x16_bf16(vf[dt][0], pf0, o[dt], 0, 0, 0);
            o[dt] = __builtin_amdgcn_mfma_f32_32x32x16_bf16(vf[dt][1], pf1, o[dt], 0, 0, 0);
        }
        if (PF) {
#pragma unroll
            for (int d0 = 0; d0 < DQK / 16; ++d0) kf[d0] = kfn[PF ? d0 : 0];
#pragma unroll
            for (int dt = 0; dt < DV / 32; ++dt) { vf[dt][0] = vfn[PF ? dt : 0][0]; vf[dt][1] = vfn[PF ? dt : 0][1]; }
            w = wn;
        }
    }
#undef ATT_LOAD
    l_run += __shfl_xor(l_run, 32);
    m_out = m_run; l_out = l_run;
}
template <int DQK, int DV, int MODE, bool QNORM, int SK, int NQ>
__device__ __forceinline__ void attn_block(LAS unsigned char* lds, const bf16_t* __restrict__ Qp, int q_pitch, int q_hoff, const bf16_t* __restrict__ Kp, int k_pitch,
                                           const bf16_t* __restrict__ Vt, int vt_pitch, int nst, int nst_w, int q0, const unsigned* __restrict__ mw, float qk_scale,
                                           f32x16 (&o)[NQ][DV / 32], float (&m_out)[NQ], float (&l_out)[NQ], const int tid) {
    constexpr int NSUB = SK / 32, KP = DQK * 2 + 16, VP = SK * 2 + 16, KBYTES = SK * KP, VBYTES = DV * VP, STAGE = KBYTES + VBYTES;
    constexpr int KCPR = DQK / 8, VCPR = SK / 8, KCH = SK * KCPR, VCH = DV * VCPR, NCH = KCH + VCH, NLD = (NCH + 511) / 512;
    static_assert(2 * STAGE <= 131072, "attention stages fit the ring region");
    const int lane = tid & 63, r32 = lane & 31, hi = lane >> 5;
    bf16x8 qf[NQ][DQK / 16];
#pragma unroll
    for (int qh = 0; qh < NQ; ++qh)
#pragma unroll
        for (int d0 = 0; d0 < DQK / 16; ++d0) qf[qh][d0] = *(const bf16x8*)(Qp + (size_t)qh * q_hoff + (size_t)r32 * q_pitch + d0 * 16 + hi * 8);
    float sscale[NQ];
#pragma unroll
    for (int qh = 0; qh < NQ; ++qh) {
        sscale[qh] = 1.0f;
        if (QNORM) {
            float ss = 0.f;
#pragma unroll
            for (int d0 = 0; d0 < DQK / 16; ++d0)
#pragma unroll
                for (int jq = 0; jq < 8; ++jq) { const float v = bf2f((unsigned)(unsigned short)qf[qh][d0][jq]); ss += v * v; }
            ss += __shfl_xor(ss, 32);
            sscale[qh] = qk_scale * __builtin_amdgcn_rsqf(ss * (1.0f / DQK) + EPS);
        }
    }
    float m_run[NQ], l_run[NQ];
#pragma unroll
    for (int qh = 0; qh < NQ; ++qh) {
        m_run[qh] = 0.f; l_run[qh] = 0.f;
#pragma unroll
        for (int dt = 0; dt < DV / 32; ++dt)
#pragma unroll
            for (int r = 0; r < 16; ++r) o[qh][dt][r] = 0.f;
    }
    int goff[NLD]; bool isk[NLD]; int gstep[NLD]; int ldst[NLD]; bool act[NLD];
#pragma unroll
    for (int i = 0; i < NLD; ++i) {
        const int c = tid + i * 512; act[i] = c < NCH;
        isk[i] = c < KCH;
        if (c < KCH) { const int row = c / KCPR, ch = c % KCPR; goff[i] = row * k_pitch + ch * 8; gstep[i] = SK * k_pitch; ldst[i] = row * KP + ch * 16; }
        else { const int c2 = c - KCH, row = c2 / VCPR, ch = c2 % VCPR; goff[i] = (row < DV ? row : 0) * vt_pitch + ch * 8; gstep[i] = SK; ldst[i] = KBYTES + row * VP + ch * 16; }
    }
    constexpr bool PF2 = (NQ == 1 && DQK <= 96);
    u32x4 stg[NLD], stg2[NLD];
    const int nstage = (nst + NSUB - 1) / NSUB;
#pragma unroll
    for (int i = 0; i < NLD; ++i) if (act[i]) stg2[i] = *(const u32x4*)((isk[i] ? Kp : Vt) + goff[i]);
    if (PF2 && 1 < nstage) {
#pragma unroll
        for (int i = 0; i < NLD; ++i) if (act[i]) stg[i] = *(const u32x4*)((isk[i] ? Kp : Vt) + goff[i] + gstep[i]);
    }
#pragma unroll
    for (int i = 0; i < NLD; ++i) if (act[i]) *(LAS u32x4*)(lds + ldst[i]) = stg2[i];
    unsigned wcur0 = 0xffffffffu, wcur1 = 0xffffffffu;
    const unsigned* mrow = (MODE == 1) ? (mw + (size_t)r32 * 64) : nullptr;
    if (MODE == 1) { wcur0 = mrow[0]; wcur1 = (NSUB > 1 && 1 < nst) ? mrow[1] : 0u; }
    __syncthreads();
    for (int sg = 0; sg < nstage; ++sg) {
        const bool more = sg + 1 < nstage;
        unsigned wn0 = 0xffffffffu, wn1 = 0xffffffffu;
        if (PF2) {
            if (sg + 2 < nstage) {
#pragma unroll
                for (int i = 0; i < NLD; ++i) if (act[i]) stg2[i] = *(const u32x4*)((isk[i] ? Kp : Vt) + goff[i] + (sg + 2) * gstep[i]);
            }
        } else if (more) {
#pragma unroll
            for (int i = 0; i < NLD; ++i) if (act[i]) stg[i] = *(const u32x4*)((isk[i] ? Kp : Vt) + goff[i] + (sg + 1) * gstep[i]);
        }
        if (more) {
            if (MODE == 1) { wn0 = mrow[NSUB * sg + NSUB]; wn1 = (NSUB > 1 && NSUB * sg + NSUB + 1 < nst) ? mrow[NSUB * sg + NSUB + 1] : 0u; }
        }
        LAS unsigned char* sb = lds + (sg & 1) * STAGE;
        if (NSUB * sg < nst_w) {
            f32x16 sc[NQ][NSUB];
#pragma unroll
            for (int qh = 0; qh < NQ; ++qh)
#pragma unroll
                for (int sub = 0; sub < NSUB; ++sub)
#pragma unroll
                    for (int r = 0; r < 16; ++r) sc[qh][sub][r] = QNORM ? 0.f : -m_run[qh];
            if (NQ == 1 && DQK <= 96) {
                bf16x8 kfa[NSUB][DQK / 16];
#pragma unroll
                for (int d0 = 0; d0 < DQK / 16; ++d0)
#pragma unroll
                    for (int sub = 0; sub < NSUB; ++sub) kfa[sub][d0] = *(const LAS bf16x8*)(sb + (sub * 32 + r32) * KP + hi * 16 + d0 * 32);
                asm volatile("s_waitcnt lgkmcnt(0)" ::: "memory");
                __builtin_amdgcn_sched_barrier(0);
                __builtin_amdgcn_s_setprio(1);
#pragma unroll
                for (int d0 = 0; d0 < DQK / 16; ++d0)
#pragma unroll
                    for (int sub = 0; sub < NSUB; ++sub) sc[0][sub] = __builtin_amdgcn_mfma_f32_32x32x16_bf16(kfa[sub][d0], qf[0][d0], sc[0][sub], 0, 0, 0);
            } else {
            __builtin_amdgcn_s_setprio(1);
#pragma unroll
            for (int d0 = 0; d0 < DQK / 16; ++d0)
#pragma unroll
                for (int sub = 0; sub < NSUB; ++sub) {
                    const bf16x8 kf = *(const LAS bf16x8*)(sb + (sub * 32 + r32) * KP + hi * 16 + d0 * 32);
#pragma unroll
                    for (int qh = 0; qh < NQ; ++qh) sc[qh][sub] = __builtin_amdgcn_mfma_f32_32x32x16_bf16(kf, qf[qh][d0], sc[qh][sub], 0, 0, 0);
                }
            }
            __builtin_amdgcn_s_setprio(0);
#pragma unroll
            for (int sub = 0; sub < NSUB; ++sub) {
                const int st = NSUB * sg + sub;
                if (QNORM) {
#pragma unroll
                    for (int qh = 0; qh < NQ; ++qh)
#pragma unroll
                        for (int r = 0; r < 16; ++r) sc[qh][sub][r] = sc[qh][sub][r] * sscale[qh] - m_run[qh];
                }
                if (MODE == 0) {
                    if (st * 32 + 31 > q0) {
#pragma unroll
                        for (int r = 0; r < 16; ++r) { if (st * 32 + crow(r, hi) > q0 + r32) {
#pragma unroll
                            for (int qh = 0; qh < NQ; ++qh) sc[qh][sub][r] = -INFINITY; } }
                    }
                } else if (MODE == 1) {
                    const unsigned w = sub ? wcur1 : wcur0;
#pragma unroll
                    for (int r = 0; r < 16; ++r) { if (((w >> crow(r, hi)) & 1u) == 0u) {
#pragma unroll
                        for (int qh = 0; qh < NQ; ++qh) sc[qh][sub][r] = -INFINITY; } }
                } else if (st >= nst_w) {
#pragma unroll
                    for (int qh = 0; qh < NQ; ++qh)
#pragma unroll
                        for (int r = 0; r < 16; ++r) sc[qh][sub][r] = -INFINITY;
                }
            }
            bf16x8 pf[NQ][NSUB][2];
#pragma unroll
            for (int qh = 0; qh < NQ; ++qh) {
                float tm = sc[qh][0][0];
#pragma unroll
                for (int sub = 0; sub < NSUB; ++sub)
#pragma unroll
                    for (int r = 0; r < 16; ++r) tm = fmaxf(tm, sc[qh][sub][r]);
                tm = fmaxf(tm, __shfl_xor(tm, 32));
                if (__ballot(tm > 0.f) != 0ull) {
                    const float dl = fmaxf(tm, 0.f); m_run[qh] += dl;
                    const float alpha = __builtin_amdgcn_exp2f(-dl);
                    l_run[qh] *= alpha;
#pragma unroll
                    for (int sub = 0; sub < NSUB; ++sub)
#pragma unroll
                        for (int r = 0; r < 16; ++r) sc[qh][sub][r] -= dl;
#pragma unroll
                    for (int dt = 0; dt < DV / 32; ++dt)
#pragma unroll
                        for (int r = 0; r < 16; ++r) o[qh][dt][r] *= alpha;
                }
                float ps = 0.f;
#pragma unroll
                for (int sub = 0; sub < NSUB; ++sub)
#pragma unroll
                    for (int r = 0; r < 16; ++r) { sc[qh][sub][r] = __builtin_amdgcn_exp2f(sc[qh][sub][r]); ps += sc[qh][sub][r]; }
                l_run[qh] += ps;
#pragma unroll
                for (int sub = 0; sub < NSUB; ++sub) {
                    u32x4 p0, p1;
                    p0.x = pg8::cvt_pk_bf16(sc[qh][sub][0], sc[qh][sub][1]); p0.y = pg8::cvt_pk_bf16(sc[qh][sub][2], sc[qh][sub][3]); p0.z = pg8::cvt_pk_bf16(sc[qh][sub][4], sc[qh][sub][5]); p0.w = pg8::cvt_pk_bf16(sc[qh][sub][6], sc[qh][sub][7]);
                    p1.x = pg8::cvt_pk_bf16(sc[qh][sub][8], sc[qh][sub][9]); p1.y = pg8::cvt_pk_bf16(sc[qh][sub][10], sc[qh][sub][11]); p1.z = pg8::cvt_pk_bf16(sc[qh][sub][12], sc[qh][sub][13]); p1.w = pg8::cvt_pk_bf16(sc[qh][sub][14], sc[qh][sub][15]);
                    pf[qh][sub][0] = __builtin_bit_cast(bf16x8, p0); pf[qh][sub][1] = __builtin_bit_cast(bf16x8, p1);
                }
            }
            __builtin_amdgcn_s_setprio(1);
#pragma unroll
            for (int sub = 0; sub < NSUB; ++sub) {
                const LAS unsigned char* vb = sb + KBYTES + r32 * VP + (sub * 32 + hi * 8) * 2;
#pragma unroll
                for (int dt = 0; dt < DV / 32; ++dt) {
                    const bf16x8 v0 = *(const LAS bf16x8*)(vb + dt * 32 * VP), v1 = *(const LAS bf16x8*)(vb + dt * 32 * VP + 32);
#pragma unroll
                    for (int qh = 0; qh < NQ; ++qh) {
                        o[qh][dt] = __builtin_amdgcn_mfma_f32_32x32x16_bf16(v0, pf[qh][sub][0], o[qh][dt], 0, 0, 0);
                        o[qh][dt] = __builtin_amdgcn_mfma_f32_32x32x16_bf16(v1, pf[qh][sub][1], o[qh][dt], 0, 0, 0);
                    }
                }
            }
            __builtin_amdgcn_s_setprio(0);
        }
        if (more) {
            LAS unsigned char* nb = lds + ((sg + 1) & 1) * STAGE;
#pragma unroll
            for (int i = 0; i < NLD; ++i) if (act[i]) *(LAS u32x4*)(nb + ldst[i]) = stg[i];
            if (PF2) {
#pragma unroll
                for (int i = 0; i < NLD; ++i) stg[i] = stg2[i];
            }
            wcur0 = wn0; wcur1 = wn1;
        }
        __syncthreads();
    }
#pragma unroll
    for (int qh = 0; qh < NQ; ++qh) { l_run[qh] += __shfl_xor(l_run[qh], 32); m_out[qh] = m_run[qh]; l_out[qh] = l_run[qh]; }
}
template <int DV> __device__ __forceinline__ void store_ot(const f32x16 (&o)[DV / 32], float inv_l, bf16_t* orow, int hi) {
#pragma unroll
    for (int dt = 0; dt < DV / 32; ++dt)
#pragma unroll
        for (int a = 0; a < 4; ++a) {
            u32x2 w; w.x = pk2(o[dt][4 * a] * inv_l, o[dt][4 * a + 1] * inv_l); w.y = pk2(o[dt][4 * a + 2] * inv_l, o[dt][4 * a + 3] * inv_l);
            *(u32x2*)(orow + dt * 32 + 8 * a + 4 * hi) = w;
        }
}

template <int DIL> __device__ __forceinline__ void vt_item(const bf16_t* __restrict__ src, size_t src_pitch, bf16_t* __restrict__ dstrow, int s0, int L, int lane) {
    unsigned v[64];
#pragma unroll
    for (int i = 0; i < 64; ++i) v[i] = src[(size_t)i * src_pitch + lane];
    const int mb = s0 / DIL;
#pragma unroll
    for (int r = 0; r < DIL; ++r)
#pragma unroll
        for (int q4 = 0; q4 < 16 / DIL; ++q4) {
            const int m_base = mb + 4 * q4, pidx = r * L + m_base, a = (m_base >> 2) & 3, slot = 8 * (a & 1) + 4 * (a >> 1);
            u32x2 w; w.x = v[(4 * q4 + 0) * DIL + r] | (v[(4 * q4 + 1) * DIL + r] << 16); w.y = v[(4 * q4 + 2) * DIL + r] | (v[(4 * q4 + 3) * DIL + r] << 16);
            *(u32x2*)(dstrow + (pidx & ~15) + slot) = w;
        }
}

template <int D> __device__ __forceinline__ void head_vec(const bf16_t* __restrict__ src, const float* __restrict__ g0, const float* __restrict__ g1, bool sel1, bool norm, bool rope,
                                                          float scale, const f32x2* __restrict__ cs, bf16_t* __restrict__ dst) {
    float v[D];
#pragma unroll
    for (int q = 0; q < D / 8; ++q) {
        const u32x4 raw = *(const u32x4*)(src + 8 * q);
        v[8 * q + 0] = bf2f(raw.x & 0xffffu); v[8 * q + 1] = bf2f(raw.x >> 16); v[8 * q + 2] = bf2f(raw.y & 0xffffu); v[8 * q + 3] = bf2f(raw.y >> 16);
        v[8 * q + 4] = bf2f(raw.z & 0xffffu); v[8 * q + 5] = bf2f(raw.z >> 16); v[8 * q + 6] = bf2f(raw.w & 0xffffu); v[8 * q + 7] = bf2f(raw.w >> 16);
    }
    float ss = 0.f;
#pragma unroll
    for (int d = 0; d < D; ++d) ss += v[d] * v[d];
    const float rs = norm ? __builtin_amdgcn_rsqf(ss * (1.0f / D) + EPS) : 1.0f;
#pragma unroll
    for (int d = 0; d < D; ++d) { const float gg = norm ? (sel1 ? g1[d] : g0[d]) : 1.0f; v[d] = v[d] * rs * gg; }
#pragma unroll
    for (int i = 0; i < D / 4; ++i) {
        const f32x4 c2 = *(const f32x4*)(cs + 2 * i);
#pragma unroll
        for (int e = 0; e < 2; ++e) {
            const int d = 2 * i + e; const float cc = rope ? c2[2 * e] : 1.0f, sn = rope ? c2[2 * e + 1] : 0.0f;
            const float a = v[d], b = v[d + D / 2];
            v[d] = (a * cc - b * sn) * scale; v[d + D / 2] = (b * cc + a * sn) * scale;
        }
    }
#pragma unroll
    for (int q = 0; q < D / 8; ++q) {
        u32x4 w; w.x = pg8::cvt_pk_bf16(v[8 * q], v[8 * q + 1]); w.y = pg8::cvt_pk_bf16(v[8 * q + 2], v[8 * q + 3]); w.z = pg8::cvt_pk_bf16(v[8 * q + 4], v[8 * q + 5]); w.w = pg8::cvt_pk_bf16(v[8 * q + 6], v[8 * q + 7]);
        *(u32x4*)(dst + 8 * q) = w;
    }
}

template <int D> __device__ __forceinline__ void head_vec8(const bf16_t* __restrict__ src, const float* __restrict__ gain, bool norm, bool rope, float scale,
                                                           const f32x2* __restrict__ cs, bf16_t* __restrict__ dst, const int sub) {
    constexpr int NH = D / 16;
    float lo[NH], hi[NH];
    if (NH == 4) {
        const u32x2 a = *(const u32x2*)(src + sub * 4), b = *(const u32x2*)(src + D / 2 + sub * 4);
        lo[0] = bf2f(a.x & 0xffffu); lo[1] = bf2f(a.x >> 16); lo[NH - 2] = bf2f(a.y & 0xffffu); lo[NH - 1] = bf2f(a.y >> 16);
        hi[0] = bf2f(b.x & 0xffffu); hi[1] = bf2f(b.x >> 16); hi[NH - 2] = bf2f(b.y & 0xffffu); hi[NH - 1] = bf2f(b.y >> 16);
    } else {
        const unsigned a = *(const unsigned*)(src + sub * 2), b = *(const unsigned*)(src + D / 2 + sub * 2);
        lo[0] = bf2f(a & 0xffffu); lo[1] = bf2f(a >> 16); hi[0] = bf2f(b & 0xffffu); hi[1] = bf2f(b >> 16);
    }
    float ss = 0.f;
#pragma unroll
    for (int i = 0; i < NH; ++i) ss += lo[i] * lo[i] + hi[i] * hi[i];
    ss += __shfl_xor(ss, 1); ss += __shfl_xor(ss, 2); ss += __shfl_xor(ss, 4);
    const float rs = norm ? __builtin_amdgcn_rsqf(ss * (1.0f / D) + EPS) : 1.0f;
    float cc[NH], sn[NH];
    if (NH == 4) {
        const f32x4 g0 = *(const f32x4*)(gain + sub * 4), g1 = *(const f32x4*)(gain + D / 2 + sub * 4);
        const f32x4 c0 = *(const f32x4*)(cs + sub * 4), c1 = *(const f32x4*)(cs + sub * 4 + 2);
#pragma unroll
        for (int i = 0; i < 4; ++i) { lo[i] *= norm ? rs * g0[i] : 1.0f; hi[i] *= norm ? rs * g1[i] : 1.0f; }
        cc[0] = c0[0]; sn[0] = c0[1]; cc[1] = c0[2]; sn[1] = c0[3]; cc[NH - 2] = c1[0]; sn[NH - 2] = c1[1]; cc[NH - 1] = c1[2]; sn[NH - 1] = c1[3];
    } else {
        const f32x2 g0 = *(const f32x2*)(gain + sub * 2), g1 = *(const f32x2*)(gain + D / 2 + sub * 2);
        const f32x4 c0 = *(const f32x4*)(cs + sub * 2);
#pragma unroll
        for (int i = 0; i < 2; ++i) { lo[i] *= norm ? rs * g0[i] : 1.0f; hi[i] *= norm ? rs * g1[i] : 1.0f; }
        cc[0] = c0[0]; sn[0] = c0[1]; cc[1] = c0[2]; sn[1] = c0[3];
    }
    float ol[NH], oh[NH];
#pragma unroll
    for (int i = 0; i < NH; ++i) {
        const float c = rope ? cc[i] : 1.0f, sv = rope ? sn[i] : 0.0f;
        ol[i] = (lo[i] * c - hi[i] * sv) * scale; oh[i] = (hi[i] * c + lo[i] * sv) * scale;
    }
    if (NH == 4) {
        u32x2 w0, w1; w0.x = pg8::cvt_pk_bf16(ol[0], ol[1]); w0.y = pg8::cvt_pk_bf16(ol[NH - 2], ol[NH - 1]); w1.x = pg8::cvt_pk_bf16(oh[0], oh[1]); w1.y = pg8::cvt_pk_bf16(oh[NH - 2], oh[NH - 1]);
        *(u32x2*)(dst + sub * 4) = w0; *(u32x2*)(dst + D / 2 + sub * 4) = w1;
    } else {
        *(unsigned*)(dst + sub * 2) = pg8::cvt_pk_bf16(ol[0], ol[1]); *(unsigned*)(dst + D / 2 + sub * 2) = pg8::cvt_pk_bf16(oh[0], oh[1]);
    }
}

struct HVRaw { u32x2 a, b; f32x4 g0, g1, c0, c1; };
template <int D> __device__ __forceinline__ void hv_load(HVRaw& r, const bf16_t* __restrict__ src, const float* __restrict__ gain, const f32x2* __restrict__ cs, const int sub) {
    if (D == 64) {
        r.a = *(const u32x2*)(src + sub * 4); r.b = *(const u32x2*)(src + 32 + sub * 4);
        r.g0 = *(const f32x4*)(gain + sub * 4); r.g1 = *(const f32x4*)(gain + 32 + sub * 4);
        r.c0 = *(const f32x4*)(cs + sub * 4); r.c1 = *(const f32x4*)(cs + sub * 4 + 2);
    } else {
        r.a.x = *(const unsigned*)(src + sub * 2); r.b.x = *(const unsigned*)(src + 16 + sub * 2); r.a.y = 0u; r.b.y = 0u;
        const f32x2 g0 = *(const f32x2*)(gain + sub * 2), g1 = *(const f32x2*)(gain + 16 + sub * 2);
        r.g0 = (f32x4){g0.x, g0.y, 0.f, 0.f}; r.g1 = (f32x4){g1.x, g1.y, 0.f, 0.f};
        r.c0 = *(const f32x4*)(cs + sub * 2); r.c1 = r.c0;
    }
}
template <int D> __device__ __forceinline__ void hv_finish(const HVRaw& r, bool norm, bool rope, float scale, bf16_t* __restrict__ dst, const int sub) {
    constexpr int NH = D / 16;
    float lo[4], hi[4], cc[4], sn[4];
    lo[0] = bf2f(r.a.x & 0xffffu); lo[1] = bf2f(r.a.x >> 16); lo[2] = bf2f(r.a.y & 0xffffu); lo[3] = bf2f(r.a.y >> 16);
    hi[0] = bf2f(r.b.x & 0xffffu); hi[1] = bf2f(r.b.x >> 16); hi[2] = bf2f(r.b.y & 0xffffu); hi[3] = bf2f(r.b.y >> 16);
    float ss = 0.f;
#pragma unroll
    for (int i = 0; i < NH; ++i) ss += lo[i] * lo[i] + hi[i] * hi[i];
    ss += __shfl_xor(ss, 1); ss += __shfl_xor(ss, 2); ss += __shfl_xor(ss, 4);
    const float rs = norm ? __builtin_amdgcn_rsqf(ss * (1.0f / D) + EPS) : 1.0f;
#pragma unroll
    for (int i = 0; i < NH; ++i) { lo[i] *= norm ? rs * r.g0[i] : 1.0f; hi[i] *= norm ? rs * r.g1[i] : 1.0f; }
    cc[0] = r.c0[0]; sn[0] = r.c0[1]; cc[1] = r.c0[2]; sn[1] = r.c0[3]; cc[2] = r.c1[0]; sn[2] = r.c1[1]; cc[3] = r.c1[2]; sn[3] = r.c1[3];
    float ol[4], oh[4];
#pragma unroll
    for (int i = 0; i < NH; ++i) {
        const float c = rope ? cc[i] : 1.0f, sv = rope ? sn[i] : 0.0f;
        ol[i] = (lo[i] * c - hi[i] * sv) * scale; oh[i] = (hi[i] * c + lo[i] * sv) * scale;
    }
    if (NH == 4) {
        u32x2 w0, w1; w0.x = pg8::cvt_pk_bf16(ol[0], ol[1]); w0.y = pg8::cvt_pk_bf16(ol[2], ol[3]); w1.x = pg8::cvt_pk_bf16(oh[0], oh[1]); w1.y = pg8::cvt_pk_bf16(oh[2], oh[3]);
        *(u32x2*)(dst + sub * 4) = w0; *(u32x2*)(dst + 32 + sub * 4) = w1;
    } else {
        *(unsigned*)(dst + sub * 2) = pg8::cvt_pk_bf16(ol[0], ol[1]); *(unsigned*)(dst + 16 + sub * 2) = pg8::cvt_pk_bf16(oh[0], oh[1]);
    }
}

template <int D> __device__ __forceinline__ void norm_vec(const bf16_t* __restrict__ src, const float* __restrict__ gain, bf16_t* __restrict__ dst, const int sub) {
    const u32x4 raw = *(const u32x4*)(src + sub * 8);
    float v[8];
    v[0] = bf2f(raw.x & 0xffffu); v[1] = bf2f(raw.x >> 16); v[2] = bf2f(raw.y & 0xffffu); v[3] = bf2f(raw.y >> 16);
    v[4] = bf2f(raw.z & 0xffffu); v[5] = bf2f(raw.z >> 16); v[6] = bf2f(raw.w & 0xffffu); v[7] = bf2f(raw.w >> 16);
    float ss = 0.f;
#pragma unroll
    for (int i = 0; i < 8; ++i) ss += v[i] * v[i];
#pragma unroll
    for (int o = 1; o < D / 8; o <<= 1) ss += __shfl_xor(ss, o);
    const float rs = __builtin_amdgcn_rsqf(ss * (1.0f / D) + EPS);
    const f32x4 g0 = *(const f32x4*)(gain + sub * 8), g1 = *(const f32x4*)(gain + sub * 8 + 4);
    u32x4 w; w.x = pg8::cvt_pk_bf16(v[0] * rs * g0[0], v[1] * rs * g0[1]); w.y = pg8::cvt_pk_bf16(v[2] * rs * g0[2], v[3] * rs * g0[3]);
    w.z = pg8::cvt_pk_bf16(v[4] * rs * g1[0], v[5] * rs * g1[1]); w.w = pg8::cvt_pk_bf16(v[6] * rs * g1[2], v[7] * rs * g1[3]);
    *(u32x4*)(dst + sub * 8) = w;
}

__device__ __forceinline__ float rope_apply(float y, float partner, f32x2 cs, bool first_half) { return first_half ? y * cs.x - partner * cs.y : y * cs.x + partner * cs.y; }

#define XB_TMO      128
#define XB_XCNT(j)  (256  + 64 * (j))
#define XB_XSUB(j)  (1280 + 64 * (j))
#define XB_XGEN(j)  (2304 + 64 * (j))
#define XB_TOP      3328
#define XB_TOPGEN   3392
#define XCD_BAR_WORDS 3456
#define XB_SPIN_CAP (1u << 18)

__device__ __forceinline__ unsigned xb_ld(unsigned* p)              { return __hip_atomic_load(p, __ATOMIC_RELAXED, __HIP_MEMORY_SCOPE_AGENT); }
__device__ __forceinline__ unsigned xb_add(unsigned* p, unsigned v) { return __hip_atomic_fetch_add(p, v, __ATOMIC_RELAXED, __HIP_MEMORY_SCOPE_AGENT); }
__device__ __forceinline__ unsigned xb_xcc_id() { return (unsigned)__builtin_amdgcn_s_getreg((3 << 11) | 20) & 0xFu; }
#define XB_SPIN(cond, bar) do { unsigned _sp = 0; while (cond) { __builtin_amdgcn_s_sleep(1); \
    if ((++_sp & 255u) == 0u) { if (xb_ld(&(bar)[XB_TMO])) break; if (_sp > XB_SPIN_CAP) { atomicAdd(&(bar)[XB_TMO], 1u); break; } } } } while (0)

struct XcdBarrier {
    unsigned* bar; unsigned x; unsigned tid;
    volatile LAS unsigned* st;
};

__device__ __forceinline__ XcdBarrier xcd_barrier_post(unsigned* bar, volatile LAS unsigned* st) {
    XcdBarrier b; b.bar = bar; b.x = xb_xcc_id(); b.st = st; b.tid = threadIdx.x;
    if (threadIdx.x == 0) (void)xb_add(&bar[XB_XCNT(b.x)], 1u);
    return b;
}
__device__ __forceinline__ void xcd_barrier_complete(unsigned* bar, unsigned x, unsigned& nloc, unsigned& nx) {
    const unsigned G = gridDim.x * gridDim.y * gridDim.z;
    unsigned sum, cnt, mine, sp = 0u;
    for (;;) {
        sum = 0u; cnt = 0u; mine = 0u;
#pragma unroll
        for (unsigned j = 0; j < 16; ++j) { const unsigned c = xb_ld(&bar[XB_XCNT(j)]); sum += c; cnt += (c > 0u) ? 1u : 0u; mine = (j == x) ? c : mine; }
        if (sum == G) break;
        __builtin_amdgcn_s_sleep(1);
        if ((++sp & 255u) == 0u) { if (xb_ld(&bar[XB_TMO])) break; if (sp > XB_SPIN_CAP) { atomicAdd(&bar[XB_TMO], 1u); break; } }
    }
    nloc = mine > 0u ? mine : 1u; nx = cnt > 0u ? cnt : 1u;
}

__device__ __forceinline__ void xcd_barrier(const XcdBarrier& b) {
    asm volatile("s_waitcnt vmcnt(0)" ::: "memory");
    __syncthreads();
    if (b.tid == 0u) {
        unsigned* bar = b.bar;
        __builtin_amdgcn_s_waitcnt(0);
        unsigned nloc = b.st[0], nx = b.st[1];
        if (nloc == 0u) { xcd_barrier_complete(bar, b.x, nloc, nx); b.st[0] = nloc; b.st[1] = nx; }
        const unsigned old = xb_add(&bar[XB_XSUB(b.x)], 1u);
        const unsigned gen = old / nloc;
        if (old + 1u == (gen + 1u) * nloc) {
            __builtin_amdgcn_fence(__ATOMIC_RELEASE, "agent");
            asm volatile("s_waitcnt vmcnt(0)" ::: "memory");
            const unsigned og = xb_add(&bar[XB_TOP], 1u);
            const unsigned tg = og / nx;
            if (og + 1u == (tg + 1u) * nx) xb_add(&bar[XB_TOPGEN], 1u);
            else XB_SPIN(xb_ld(&bar[XB_TOPGEN]) == tg, bar);
            __builtin_amdgcn_fence(__ATOMIC_ACQUIRE, "agent");
            xb_add(&bar[XB_XGEN(b.x)], 1u);
            asm volatile("s_waitcnt vmcnt(0)" ::: "memory");
        } else {
            XB_SPIN(xb_ld(&bar[XB_XGEN(b.x)]) == gen, bar);
            __builtin_amdgcn_fence(__ATOMIC_ACQUIRE, "agent");
            asm volatile("s_waitcnt vmcnt(0)" ::: "memory");
        }
    }
    __syncthreads();
}

struct KArgs { const void* in[31]; float* out; unsigned char* ws; };

__global__ void __launch_bounds__(512, 2) mega_fwd(KArgs a) {
    extern __shared__ __attribute__((aligned(16))) unsigned char lds_raw[];
    LAS unsigned char* lds = (LAS unsigned char*)lds_raw;
    cg::grid_group grid = cg::this_grid();
    const int wave_s = __builtin_amdgcn_readfirstlane((int)(threadIdx.x >> 6));
#define TIDX (wave_s * 64 + (int)__builtin_amdgcn_mbcnt_hi(~0u, __builtin_amdgcn_mbcnt_lo(~0u, 0u)))
#ifdef REP_ATT
#define ATT_REP for (int rep_ = 0; rep_ < 2; ++rep_)
#else
#define ATT_REP
#endif
#ifdef REP_IDX
#define IDX_REP for (int rep_ = 0; rep_ < 2; ++rep_)
#else
#define IDX_REP
#endif
#ifdef REP_EWA
#define EWA_REP for (int rep_ = 0; rep_ < 2; ++rep_)
#else
#define EWA_REP
#endif
#ifdef REP_EWB
#define EWB_REP for (int rep_ = 0; rep_ < 2; ++rep_)
#else
#define EWB_REP
#endif
#define PH_VARS KA_DEF int tid = TIDX; asm volatile("" : "+v"(tid)); const int lane = tid & 63, wave = __builtin_amdgcn_readfirstlane(tid >> 6); \
    const int gw = blockIdx.x * 8 + wave; constexpr int NGW = GRID_BLOCKS * 8; const int r32 = lane & 31, hi = lane >> 5; LAS float* scr = (LAS float*)(lds + wave * 16384); \
    (void)gw; (void)NGW; (void)r32; (void)hi; (void)scr;

#define KA_DEF const __attribute__((address_space(4))) KArgs* ka_ = (const __attribute__((address_space(4))) KArgs*)__builtin_amdgcn_kernarg_segment_ptr(); asm volatile("" : "+s"(ka_));
#define KA_ ka_
#define INF(k) ((const float*)KA_->in[k])
#define x_in INF(0)
#define mem_in INF(1)
#define pos_in ((const int*)KA_->in[2])
#define ffn1_norm INF(3)
#define ffn1_w13 INF(4)
#define ffn1_w2 INF(5)
#define mix_norm INF(6)
#define xattn_norm INF(7)
#define mem_norm INF(8)
#define xattn_wq INF(9)
#define xattn_wkv INF(10)
#define xattn_qg INF(11)
#define xattn_kg INF(12)
#define xattn_wo INF(13)
#define ffn2_norm INF(14)
#define ffn2_w13 INF(15)
#define ffn2_w2 INF(16)
#define even_w_in INF(17)
#define mla_qlora_g INF(18)
#define mla_kvlora_g INF(19)
#define mla_w_uq INF(20)
#define mla_w_ukv INF(21)
#define mla_q_g INF(22)
#define mla_k_g INF(23)
#define dil_q_g INF(24)
#define dil_k_g INF(25)
#define even_w_out INF(26)
#define odd_w_in INF(27)
#define sp_q_g INF(28)
#define sp_k_g INF(29)
#define odd_w_out INF(30)
#define X (KA_->out)
#define WSP(off) (KA_->ws + (off))
#define Wl ((bf16_t*)WSP(WS_W))
#define XKV ((bf16_t*)WSP(WS_XKV))
#define KX ((bf16_t*)WSP(WS_KX))
#define VTX ((bf16_t*)WSP(WS_VTX))
#define XB ((bf16_t*)WSP(WS_XB))
#define SSQ ((float*)WSP(WS_SSQ))
#define MEMB ((bf16_t*)WSP(WS_MEMB))
#define MEMSSQ ((float*)WSP(WS_MEMSSQ))
#define CS64 ((f32x2*)WSP(WS_CS64))
#define CS32 ((f32x2*)WSP(WS_CS32))
#define RA ((bf16_t*)WSP(WS_A))
#define QD ((bf16_t*)WSP(WS_B + B_QD))
#define KD ((bf16_t*)WSP(WS_B + B_KD))
#define VTD ((bf16_t*)WSP(WS_B + B_VTD))
#define QM ((bf16_t*)WSP(WS_B + B_QM))
#define KM ((bf16_t*)WSP(WS_B + B_KM))
#define VTM ((bf16_t*)WSP(WS_B + B_VTM))
#define CQKV ((bf16_t*)WSP(WS_B + B_CQKV))
#define KROPE ((bf16_t*)WSP(WS_B + B_KROPE))
#define QSP ((bf16_t*)WSP(WS_B + B_QSP))
#define QI ((bf16_t*)WSP(WS_B + B_QI))
#define KSP ((bf16_t*)WSP(WS_B + B_KSP))
#define VTSP ((bf16_t*)WSP(WS_B + B_VTSP))
#define KI ((bf16_t*)WSP(WS_B + B_KI))
#define WI ((float*)WSP(WS_B + B_WI))
#define MASKW ((unsigned*)WSP(WS_B + B_MASKW))
#define KVRAW ((bf16_t*)WSP(WS_B + B_KVRAW))
#define MIX ((bf16_t*)WSP(WS_A + A_MIX))
#define ODIL ((bf16_t*)WSP(WS_A + A_ODIL))
#define LSE ((float*)WSP(WS_A + A_LSE))
#define OX ((bf16_t*)WSP(WS_A + A_OX))

    volatile LAS unsigned* MISC = (volatile LAS unsigned*)(lds + 131072 + 320);
    if (threadIdx.x < 32) MISC[threadIdx.x] = 0u;
    __syncthreads();
    { KA_DEF (void)xcd_barrier_post((unsigned*)WSP(WS_CTL), MISC + 8); }
#define XSYNC() do { KA_DEF XcdBarrier b_; b_.tid = (unsigned)TIDX; b_.bar = (unsigned*)WSP(WS_CTL); b_.x = xb_xcc_id(); b_.st = (volatile LAS unsigned*)(lds + 131072 + 320) + 8; xcd_barrier(b_); } while (0)
#ifdef REP_SYNC
#define GSYNC() do { XSYNC(); XSYNC(); } while (0)
#else
#define GSYNC() XSYNC()
#endif
#define CONV_JOB(Wp, Gp, KK, NS, NP, DSTP, LDD, KOFF, ROFF, ILV) { const int ni_ = ((KK) / 64) * (((NP) + 127) / 128); \
        if (r < ni_) { conv_item(Wp, Gp, KK, NS, NP, DSTP, LDD, KOFF, ROFF, ILV, scr, r, lane); continue; } r -= ni_; }
#define CONV_LAYER(l) do { const int l_ = (l), j_ = l_ >> 1; const bool ev_ = (l_ & 1) == 0; \
        for (int it = gw;; it += NGW) { int r = it; \
            CONV_JOB(ffn1_w13 + (size_t)l_ * 1024 * 5632, ffn1_norm + l_ * 1024, 1024, 5632, 5632, Wl + WO_13A, 1024, 0, 0, FF) \
            CONV_JOB(ffn1_w2 + (size_t)l_ * 2816 * 1024, (const float*)nullptr, 2816, 1024, 1024, Wl + WO_2A, 2816, 0, 0, 0) \
            CONV_JOB(ffn2_w13 + (size_t)l_ * 1024 * 5632, ffn2_norm + l_ * 1024, 1024, 5632, 5632, Wl + WO_13B, 1024, 0, 0, FF) \
            CONV_JOB(ffn2_w2 + (size_t)l_ * 2816 * 1024, (const float*)nullptr, 2816, 1024, 1024, Wl + WO_2B, 2816, 0, 0, 0) \
            CONV_JOB(xattn_wq + (size_t)l_ * 1024 * 1024, xattn_norm + l_ * 1024, 1024, 1024, 1024, Wl + WO_XQ, 1024, 0, 0, 0) \
            CONV_JOB(xattn_wo + (size_t)l_ * 1024 * 1024, (const float*)nullptr, 1024, 1024, 1024, Wl + WO_XO, 1024, 0, 0, 0) \
            if (ev_) { \
                CONV_JOB(even_w_in + (size_t)j_ * 1024 * EVEN_IN, mix_norm + l_ * 1024, 1024, EVEN_IN, EVEN_INP, Wl + WO_WIN, 1024, 0, 0, 0) \
                CONV_JOB(mla_w_uq + (size_t)j_ * 256 * 768, (const float*)nullptr, 256, 768, 768, Wl + WO_BD, 384, 0, 0, 0) \
                CONV_JOB(mla_w_ukv + (size_t)j_ * 128 * 1024, (const float*)nullptr, 128, 1024, 1024, Wl + WO_BD, 384, 256, 768, 0) \
                CONV_JOB((const float*)nullptr, (const float*)nullptr, 128, 768, 768, Wl + WO_BD, 384, 256, 0, 0) \
                CONV_JOB((const float*)nullptr, (const float*)nullptr, 256, 1024, 1024, Wl + WO_BD, 384, 0, 768, 0) \
                CONV_JOB(even_w_out + (size_t)j_ * 768 * 1024, (const float*)nullptr, 768, 1024, 1024, Wl + WO_WOUT, 768, 0, 0, 0) \
            } else { \
                CONV_JOB(odd_w_in + (size_t)j_ * 1024 * ODD_IN, mix_norm + l_ * 1024, 1024, ODD_IN, ODD_INP, Wl + WO_WIN, 1024, 0, 0, 0) \
                CONV_JOB(odd_w_out + (size_t)j_ * 1024 * 1024, (const float*)nullptr, 1024, 1024, 1024, Wl + WO_WOUT, 1024, 0, 0, 0) \
            } \
            break; } } while (0)

    { PH_VARS EWA_REP {
    CONV_LAYER(0);
    for (int it = gw;; it += NGW) { int r = it;
        CONV_JOB(xattn_wkv + (size_t)0 * 1024 * 2048, mem_norm + 0 * 1024, 1024, 2048, 2048, XKV + (size_t)0 * 2048 * 1024, 1024, 0, 0, 0)
        CONV_JOB(xattn_wkv + (size_t)1 * 1024 * 2048, mem_norm + 1 * 1024, 1024, 2048, 2048, XKV + (size_t)1 * 2048 * 1024, 1024, 0, 0, 0)
        CONV_JOB(xattn_wkv + (size_t)2 * 1024 * 2048, mem_norm + 2 * 1024, 1024, 2048, 2048, XKV + (size_t)2 * 2048 * 1024, 1024, 0, 0, 0)
        CONV_JOB(xattn_wkv + (size_t)3 * 1024 * 2048, mem_norm + 3 * 1024, 1024, 2048, 2048, XKV + (size_t)3 * 2048 * 1024, 1024, 0, 0, 0)
        break; }
    for (int m0 = gw; m0 < T_ + NBATCH * MEMLEN; m0 += 2 * NGW) {
        f32x4 v[2][4]; bool ok[2];
#pragma unroll
        for (int u2 = 0; u2 < 2; ++u2) {
            const int m = m0 + u2 * NGW; ok[u2] = m < T_ + NBATCH * MEMLEN;
            const bool is_x = m < T_; const int row = is_x ? m : m - T_;
            const f32x4* xr = (const f32x4*)((is_x ? x_in : mem_in) + (size_t)row * DM) + lane;
#pragma unroll
            for (int j = 0; j < 4; ++j) v[u2][j] = ok[u2] ? xr[64 * j] : (f32x4){0.f, 0.f, 0.f, 0.f};
        }
#pragma unroll
        for (int u2 = 0; u2 < 2; ++u2) {
            const int m = m0 + u2 * NGW;
            const bool is_x = m < T_; const int row = is_x ? m : m - T_;
            float sacc = 0.f;
#pragma unroll
            for (int j = 0; j < 4; ++j) sacc += (v[u2][j][0] * v[u2][j][0] + v[u2][j][1] * v[u2][j][1]) + (v[u2][j][2] * v[u2][j][2] + v[u2][j][3] * v[u2][j][3]);
            sacc = wave_sum(sacc);
            if (ok[u2]) {
                bf16_t* ob = (is_x ? XB : MEMB) + (size_t)row * DM; float* sq = (is_x ? SSQ : MEMSSQ) + (size_t)row * 16;
#pragma unroll
                for (int j = 0; j < 4; ++j) {
                    u32x2 w; w.x = pk2(v[u2][j][0], v[u2][j][1]); w.y = pk2(v[u2][j][2], v[u2][j][3]);
                    ((u32x2*)ob + lane)[64 * j] = w;
                }
                if (lane < 16) sq[lane] = (lane == 0) ? sacc : 0.f;
            }
        }
    }
    for (int e = blockIdx.x * 512 + tid; e < T_ * 48; e += GRID_BLOCKS * 512) {
        const int t = e / 48, c = e % 48; const bool is64 = c < 32; const int i = is64 ? c : c - 32; const int dim = is64 ? 64 : 32;
        const float ex = (-9.210340371976184f * (float)(2 * i)) / (float)dim;
        const float inv = expf(ex);
        const float ang = (float)pos_in[t] * inv;
        const double ad = (double)ang; const double kq = rint(ad * 0.6366197723675814); const double rr = ad - kq * 1.5707963267948966;
        const double r2 = rr * rr;
        const double sn = rr * (1.0 + r2 * (-1.0 / 6 + r2 * (1.0 / 120 + r2 * (-1.0 / 5040 + r2 * (1.0 / 362880 + r2 * (-1.0 / 39916800))))));
        const double cn = 1.0 + r2 * (-0.5 + r2 * (1.0 / 24 + r2 * (-1.0 / 720 + r2 * (1.0 / 40320 + r2 * (-1.0 / 3628800 + r2 * (1.0 / 479001600))))));
        const int q = ((int)kq) & 3;
        const double cc = (q == 0) ? cn : (q == 1) ? -sn : (q == 2) ? -cn : sn;
        const double sv = (q == 0) ? sn : (q == 1) ? cn : (q == 2) ? -sn : -cn;
        f32x2 o; o.x = (float)cc; o.y = (float)sv;
        if (is64) CS64[(size_t)t * 32 + i] = o; else CS32[(size_t)t * 16 + i] = o;
    }
    } }
    if (gridDim.y == 0x7fffu) grid.sync();
    GSYNC();

    { KA_DEF pg8::EpiBf16S E{KVRAW, 8192, MEMSSQ}; run_gemm(TIDX, lds, MEMB, XKV, NBATCH * MEMLEN, 8192, 1024, E); }
    GSYNC();
    { PH_VARS EWA_REP {
    for (int e = gw * 64 + lane; e < NL * 2048 * 4 * 32; e += NGW * 64) {
        const int vec = e >> 5, sub = lane & 31, h = vec & 3, row = (vec >> 2) & 2047, l = vec >> 13, b = row >> 8, m = row & 255;
        const u32x4 raw = *(const u32x4*)(KVRAW + (size_t)row * 8192 + l * 2048 + h * 256 + sub * 8);
        const f32x4 k0 = *(const f32x4*)(xattn_kg + l * 256 + sub * 8), k1 = *(const f32x4*)(xattn_kg + l * 256 + sub * 8 + 4);
        const f32x4 q0 = *(const f32x4*)(xattn_qg + l * 256 + sub * 8), q1 = *(const f32x4*)(xattn_qg + l * 256 + sub * 8 + 4);
        float v[8];
        v[0] = bf2f(raw.x & 0xffffu); v[1] = bf2f(raw.x >> 16); v[2] = bf2f(raw.y & 0xffffu); v[3] = bf2f(raw.y >> 16);
        v[4] = bf2f(raw.z & 0xffffu); v[5] = bf2f(raw.z >> 16); v[6] = bf2f(raw.w & 0xffffu); v[7] = bf2f(raw.w >> 16);
        float ss = 0.f;
#pragma unroll
        for (int i = 0; i < 8; ++i) ss += v[i] * v[i];
        ss += __shfl_xor(ss, 1); ss += __shfl_xor(ss, 2); ss += __shfl_xor(ss, 4); ss += __shfl_xor(ss, 8); ss += __shfl_xor(ss, 16);
        const float rs = __builtin_amdgcn_rsqf(ss * (1.0f / 256.0f) + EPS);
        u32x4 w; w.x = pg8::cvt_pk_bf16(v[0] * rs * k0[0] * q0[0], v[1] * rs * k0[1] * q0[1]); w.y = pg8::cvt_pk_bf16(v[2] * rs * k0[2] * q0[2], v[3] * rs * k0[3] * q0[3]);
        w.z = pg8::cvt_pk_bf16(v[4] * rs * k1[0] * q1[0], v[5] * rs * k1[1] * q1[1]); w.w = pg8::cvt_pk_bf16(v[6] * rs * k1[2] * q1[2], v[7] * rs * k1[3] * q1[3]);
        *(u32x4*)(KX + ((size_t)((l * 8 + b) * 4 + h) * 256 + m) * 256 + sub * 8) = w;
    }
    for (int it = gw; it < 2048; it += NGW) {
        const int dq = it & 3, ch = (it >> 2) & 3, h = (it >> 4) & 3, b = (it >> 6) & 7, l = it >> 9;
        const bf16_t* src = KVRAW + (size_t)(b * 256 + ch * 64) * 8192 + l * 2048 + 1024 + h * 256 + dq * 64;
        bf16_t* dst = VTX + ((size_t)((l * 8 + b) * 4 + h) * 256 + dq * 64 + lane) * 256;
        vt_item<1>(src, 8192, dst, ch * 64, 256, lane);
    }
    } }
    GSYNC();

#pragma unroll 1
    for (int l = 0; l < NL; ++l) {
        const int j = l >> 1; const bool even = (l & 1) == 0;
        if (l > 0) { { PH_VARS EWA_REP { CONV_LAYER(l); } } GSYNC(); }
        { KA_DEF pg8::EpiSwiGLU E{RA, FF, SSQ}; run_gemm(TIDX, lds, XB, Wl + WO_13A, T_, 2 * FF, 1024, E); }
        GSYNC();
        { KA_DEF pg8::EpiResid E{(l == 0) ? x_in : (const float*)X, X, XB, SSQ, 0.5f}; run_gemm(TIDX, lds, RA, Wl + WO_2A, T_, 1024, FF, E); }
        GSYNC();
        const int ldc = even ? EVEN_INP : ODD_INP;
        { KA_DEF pg8::EpiBf16S E{RA, ldc, SSQ}; run_gemm(TIDX, lds, XB, Wl + WO_WIN, T_, ldc, 1024, E); }
        GSYNC();
        if (even) {
            { PH_VARS EWB_REP {
            const float* qlg = mla_qlora_g + j * 256; const float* kvlg = mla_kvlora_g + j * 128; const float* mkg = mla_k_g + j * 96;
            const float* dqg = dil_q_g + j * 64; const float* dkg = dil_k_g + j * 64;
            for (int e = gw * 64 + lane; e < T_ * 32; e += NGW * 64) {
                const int t = e >> 5;
                norm_vec<256>(RA + (size_t)t * EVEN_INP, qlg, CQKV + (size_t)t * 384, lane & 31);
            }
            for (int e = gw * 64 + lane; e < T_ * 16; e += NGW * 64) {
                const int t = e >> 4;
                norm_vec<128>(RA + (size_t)t * EVEN_INP + 256, kvlg, CQKV + (size_t)t * 384 + 256, lane & 15);
            }
            for (int e = gw * 64 + lane; e < T_ * 8; e += NGW * 64) {
                const int t = e >> 3;
                head_vec8<32>(RA + (size_t)t * EVEN_INP + 384, mkg + 64, true, true, 1.0f, CS32 + (size_t)t * 16, KROPE + (size_t)t * 32, lane & 7);
            }
            for (int e0 = gw * 64 + lane; e0 < T_ * 24 * 8; e0 += NGW * 64 * 4) {
                HVRaw hr[4]; bf16_t* dsts[4]; bool isk[4];
#pragma unroll
                for (int u4 = 0; u4 < 4; ++u4) {
                    const int ev = (e0 + u4 * NGW * 64) >> 3, t = ev / 24, gq = ev - t * 24, g = gq >> 3, qk = (gq >> 2) & 1, h = gq & 3, b = t >> 11, sq = t & 2047;
                    const int sh = (g == 0) ? 0 : (g == 1) ? 2 : 4;
                    const int pi = ((sq & ((1 << sh) - 1)) << (11 - sh)) + (sq >> sh);
                    dsts[u4] = (qk ? KD : QD) + ((size_t)((b * 3 + g) * 4 + h) * 2048 + pi) * 64; isk[u4] = qk != 0;
                    hv_load<64>(hr[u4], RA + (size_t)t * EVEN_INP + 416 + ((g * 3 + qk) * 4 + h) * 64, qk ? dkg : dqg, CS64 + (size_t)t * 32, lane & 7);
                }
#pragma unroll
                for (int u4 = 0; u4 < 4; ++u4) hv_finish<64>(hr[u4], true, true, isk[u4] ? 1.0f : 0.125f * LOG2E, dsts[u4], lane & 7);
            }
            for (int it = gw; it < 8 * 32 * 12; it += NGW) {
                const int gh = it % 12, ch = (it / 12) & 31, b = it / (12 * 32), g = gh >> 2, h = gh & 3;
                const bf16_t* src = RA + (size_t)(b * S_ + ch * 64) * EVEN_INP + 416 + ((g * 3 + 2) * 4 + h) * 64;
                bf16_t* dst = VTD + ((size_t)((b * 3 + g) * 4 + h) * 64 + lane) * 2048;
                if (g == 0) vt_item<1>(src, EVEN_INP, dst, ch * 64, 2048, lane);
                else if (g == 1) vt_item<4>(src, EVEN_INP, dst, ch * 64, 512, lane);
                else vt_item<16>(src, EVEN_INP, dst, ch * 64, 128, lane);
            }
            } }
            GSYNC();
            { KA_DEF pg8::EpiBf16S E{RA, 1792, nullptr}; run_gemm(TIDX, lds, CQKV, Wl + WO_BD, T_, 1792, 384, E); }
            GSYNC();
            { PH_VARS EWB_REP {
            const float* mqg = mla_q_g + j * 96; const float* mkg = mla_k_g + j * 96;
            const float SCQ = 0.10206207261596577f * LOG2E;
            for (int e0 = gw * 64 + lane; e0 < T_ * 16 * 8; e0 += NGW * 64 * 4) {
                HVRaw hr[4]; bf16_t* dsts[4]; bool isk[4];
#pragma unroll
                for (int u4 = 0; u4 < 4; ++u4) {
                    const int ev = (e0 + u4 * NGW * 64) >> 3, t = ev >> 4, which = (ev >> 3) & 1, h = ev & 7;
                    dsts[u4] = (which ? KM : QM) + ((size_t)t * 8 + h) * 96; isk[u4] = which != 0;
                    hv_load<64>(hr[u4], RA + (size_t)t * 1792 + (which ? 768 + h * 128 : h * 96), which ? mkg : mqg, CS64, lane & 7);
                }
#pragma unroll
                for (int u4 = 0; u4 < 4; ++u4) hv_finish<64>(hr[u4], true, false, isk[u4] ? 1.0f : SCQ, dsts[u4], lane & 7);
            }
            for (int e0 = gw * 64 + lane; e0 < T_ * 8 * 8; e0 += NGW * 64 * 2) {
                HVRaw hr[2]; u32x2 kr[2];
                const int sub = lane & 7;
#pragma unroll
                for (int u2 = 0; u2 < 2; ++u2) {
                    const int ev = (e0 + u2 * NGW * 64) >> 3, t = ev >> 3, h = ev & 7;
                    hv_load<32>(hr[u2], RA + (size_t)t * 1792 + h * 96 + 64, mqg + 64, CS32 + (size_t)t * 16, sub);
                    kr[u2] = *(const u32x2*)(KROPE + (size_t)t * 32 + sub * 4);
                }
#pragma unroll
                for (int u2 = 0; u2 < 2; ++u2) {
                    const int ev = (e0 + u2 * NGW * 64) >> 3, t = ev >> 3, h = ev & 7;
                    hv_finish<32>(hr[u2], true, true, SCQ, QM + ((size_t)t * 8 + h) * 96 + 64, sub);
                    *(u32x2*)(KM + ((size_t)t * 8 + h) * 96 + 64 + sub * 4) = kr[u2];
                }
            }
            for (int it = gw; it < 8 * 32 * 8; it += NGW) {
                const int h = it & 7, ch = (it >> 3) & 31, b = it >> 8;
                const bf16_t* src = RA + (size_t)(b * S_ + ch * 64) * 1792 + 768 + h * 128 + 64;
                bf16_t* dst = VTM + ((size_t)(b * 8 + h) * 64 + lane) * 2048;
                vt_item<1>(src, 1792, dst, ch * 64, 2048, lane);
            }
            } }
            GSYNC();
            { PH_VARS
            ATT_REP
            for (int ub = blockIdx.x; ub < 512; ub += GRID_BLOCKS) {
                const int pass = ub >> 8, idx = ub & 255, bh = idx & 63, i = idx >> 6, qb = pass ? i : 7 - i, b = bh >> 3, h = bh & 7;
                const int qt = qb * 8 + wave, q0 = qt * 32;
                f32x16 o[1][2]; float mm[1], ll[1];
                attn_block<96, 64, 0, false, 64, 1>(lds, QM + ((size_t)(b * S_ + q0) * 8 + h) * 96, 768, 0, KM + ((size_t)b * S_ * 8 + h) * 96, 768,
                                      VTM + (size_t)(b * 8 + h) * 64 * 2048, 2048, qb * 8 + 8, qt + 1, q0, nullptr, 0.f, o, mm, ll, tid);
                store_ot<64>(o[0], 1.0f / ll[0], MIX + (size_t)(b * S_ + q0 + r32) * 768 + h * 64, hi);
            }
            for (int u = gw; u < 6144; u += NGW) {
                f32x16 o[2]; float mm, ll;
                {
                    const int v = u, g = v >> 11, rest = v & 2047, qtile = rest & 63, b = (rest >> 6) & 7, h = rest >> 9;
                    const int sh = (g == 0) ? 0 : (g == 1) ? 2 : 4, Lg = 2048 >> sh, p0 = qtile * 32, rr = p0 / Lg, m0 = p0 % Lg;
                    const size_t base = (size_t)((b * 3 + g) * 4 + h);
                    const int ktl = (m0 >> 5) - 4 < 0 ? 0 : (m0 >> 5) - 4;
                    attn_tile<64, 64, 0, false, true>(QD + (base * 2048 + p0) * 64, 64, KD + (base * 2048 + (size_t)rr * Lg) * 64, 64,
                                                VTD + base * 64 * 2048 + (size_t)rr * Lg, 2048, ktl, (m0 >> 5) + 1, m0, 0, 128, nullptr, 0.f, o, mm, ll, lane);
                    const int s = ((m0 + r32) << sh) + rr; const size_t t = (size_t)b * S_ + s;
                    store_ot<64>(o, 1.0f / ll, ODIL + (t * 12 + g * 4 + h) * 64, hi);
                    if (hi == 0) LSE[t * 12 + g * 4 + h] = mm + log2f(ll);
                }
            }
            }
            GSYNC();
            { PH_VARS EWB_REP {
            for (int e = gw * 64 + lane; e < T_ * 32; e += NGW * 64) {
                const int t = e >> 5, h = (e >> 3) & 3, ch = e & 7;
                const float l0 = LSE[(size_t)t * 12 + h], l1 = LSE[(size_t)t * 12 + 4 + h], l2 = LSE[(size_t)t * 12 + 8 + h];
                const u32x4 a0 = *(const u32x4*)(ODIL + ((size_t)t * 12 + h) * 64 + ch * 8), a1 = *(const u32x4*)(ODIL + ((size_t)t * 12 + 4 + h) * 64 + ch * 8), a2 = *(const u32x4*)(ODIL + ((size_t)t * 12 + 8 + h) * 64 + ch * 8);
                const float mx = fmaxf(l0, fmaxf(l1, l2));
                float w0 = __builtin_amdgcn_exp2f(l0 - mx), w1 = __builtin_amdgcn_exp2f(l1 - mx), w2 = __builtin_amdgcn_exp2f(l2 - mx);
                const float inv = __builtin_amdgcn_rcpf(w0 + w1 + w2); w0 *= inv; w1 *= inv; w2 *= inv;
                u32x4 o;
#pragma unroll
                for (int q = 0; q < 4; ++q) {
                    const float lo = w0 * bf2f(a0[q] & 0xffffu) + w1 * bf2f(a1[q] & 0xffffu) + w2 * bf2f(a2[q] & 0xffffu);
                    const float hi2 = w0 * bf2f(a0[q] >> 16) + w1 * bf2f(a1[q] >> 16) + w2 * bf2f(a2[q] >> 16);
                    o[q] = pg8::cvt_pk_bf16(lo, hi2);
                }
                *(u32x4*)(MIX + (size_t)t * 768 + 512 + h * 64 + ch * 8) = o;
            }
            } }
            GSYNC();
            { KA_DEF pg8::EpiResid E{X, X, XB, SSQ, 1.0f}; run_gemm(TIDX, lds, MIX, Wl + WO_WOUT, T_, 1024, 768, E); }
            GSYNC();
        } else {
            { PH_VARS EWB_REP {
            const float* qg = sp_q_g + j * 64; const float* kg = sp_k_g + j * 64;
            for (int e0 = gw * 64 + lane; e0 < T_ * 26 * 8; e0 += NGW * 64 * 2) {
                HVRaw hr[2]; bf16_t* dsts[2]; int hhs[2];
#pragma unroll
                for (int u2 = 0; u2 < 2; ++u2) {
                    const int ev = (e0 + u2 * NGW * 64) >> 3, t = ev / 26, hh = ev - t * 26;
                    const int off = (hh < 16) ? hh * 64 : (hh == 16) ? 1024 : (hh < 25) ? 1152 + (hh - 17) * 64 : 1664;
                    dsts[u2] = (hh < 16) ? QSP + ((size_t)t * 16 + hh) * 64 : (hh == 16) ? KSP + (size_t)t * 64 : (hh < 25) ? QI + ((size_t)t * 8 + (hh - 17)) * 64 : KI + (size_t)t * 64;
                    hhs[u2] = hh;
                    hv_load<64>(hr[u2], RA + (size_t)t * ODD_INP + off, (hh == 16) ? kg : qg, CS64 + (size_t)t * 32, lane & 7);
                }
#pragma unroll
                for (int u2 = 0; u2 < 2; ++u2) hv_finish<64>(hr[u2], hhs[u2] <= 16, true, (hhs[u2] < 16) ? 0.125f * LOG2E : 1.0f, dsts[u2], lane & 7);
            }
            for (int e = gw * 64 + lane; e < T_ * 8; e += NGW * 64) {
                const int t = e >> 3, i = e & 7;
                WI[e] = bf2f(RA[(size_t)t * ODD_INP + 1728 + i]) * (0.35355339059327373f * 0.125f);
            }
            for (int it = gw; it < 8 * 32; it += NGW) {
                const int ch = it & 31, b = it >> 5;
                vt_item<1>(RA + (size_t)(b * S_ + ch * 64) * ODD_INP + 1088, ODD_INP, VTSP + ((size_t)b * 64 + lane) * 2048, ch * 64, 2048, lane);
            }
            } }
            GSYNC();
#ifndef SKIP_IDX
            { PH_VARS
            IDX_REP
            for (int ub = blockIdx.x; ub < 1024; ub += GRID_BLOCKS) {
                const int pass = ub >> 8, idx = ub & 255, b = idx & 7, i = idx >> 3;
                const int c16 = (pass == 0) ? 127 - i : (pass == 1) ? i : (pass == 2) ? 95 - i : 32 + i;
                const int t0 = c16 * 16 + wave * 2; const size_t tok0 = (size_t)b * S_ + t0;
                const int n = lane & 15, fq = lane >> 4, qs = fq >> 1, odd = fq & 1;
                bf16x8 qa[2];
#pragma unroll
                for (int kk = 0; kk < 2; ++kk) qa[kk] = *(const bf16x8*)(QI + ((tok0 + (n >> 3)) * 8 + (n & 7)) * 64 + kk * 32 + fq * 8);
                const f32x4 wv = *(const f32x4*)(WI + (tok0 + qs) * 8 + 4 * odd);
                const int tq = t0 + qs;
                constexpr int IKP = 144, ISTG = 256 * IKP;
                const int nstg = (c16 * 16 + 16 + 255) >> 8;
                const bf16_t* kib = KI + (size_t)b * S_ * 64;
                u32x4 stg[4];
#pragma unroll
                for (int q = 0; q < 4; ++q) stg[q] = *(const u32x4*)(kib + (size_t)(tid + q * 512) * 8);
#pragma unroll
                for (int q = 0; q < 4; ++q) { const int c = tid + q * 512; *(LAS u32x4*)(lds + (c >> 3) * IKP + (c & 7) * 16) = stg[q]; }
                __syncthreads();
                unsigned key[64];
#pragma unroll
                for (int sg = 0; sg < 8; ++sg) {
                    if (sg < nstg) {
                        const bool more = sg + 1 < nstg;
                        if (more) {
#pragma unroll
                            for (int q = 0; q < 4; ++q) stg[q] = *(const u32x4*)(kib + (size_t)(sg + 1) * 256 * 64 + (size_t)(tid + q * 512) * 8);
                        }
                        const LAS unsigned char* sb = lds + (sg & 1) * ISTG;
#pragma unroll
                        for (int j8 = 0; j8 < 8; ++j8) {
                            const int jj = sg * 8 + j8;
                            unsigned kv = 0u;
                            {
                                float sc2[2];
#pragma unroll
                                for (int tt = 0; tt < 2; ++tt) {
                                    const LAS unsigned char* kb = sb + ((2 * j8 + tt) * 16 + n) * IKP + fq * 16;
                                    f32x4 c4 = {0.f, 0.f, 0.f, 0.f};
                                    c4 = __builtin_amdgcn_mfma_f32_16x16x32_bf16(qa[0], *(const LAS bf16x8*)(kb), c4, 0, 0, 0);
                                    c4 = __builtin_amdgcn_mfma_f32_16x16x32_bf16(qa[1], *(const LAS bf16x8*)(kb + 64), c4, 0, 0, 0);
                                    float sc = wv[0] * fmaxf(c4[0], 0.f) + wv[1] * fmaxf(c4[1], 0.f) + wv[2] * fmaxf(c4[2], 0.f) + wv[3] * fmaxf(c4[3], 0.f);
                                    sc += __shfl_xor(sc, 16);
                                    sc2[tt] = sc;
                                }
                                float sc = odd ? sc2[1] : sc2[0];
                                if (sc == 0.f) sc = 0.f;
                                const unsigned ubits = __float_as_uint(sc);
                                kv = (ubits & 0x80000000u) ? ~ubits : (ubits | 0x80000000u);
                                if (32 * jj + 16 * odd + n > tq) kv = 0u;
                            }
                            key[jj] = kv;
                        }
                        if (more) {
                            LAS unsigned char* nb = lds + ((sg + 1) & 1) * ISTG;
#pragma unroll
                            for (int q = 0; q < 4; ++q) { const int c = tid + q * 512; *(LAS u32x4*)(nb + (c >> 3) * IKP + (c & 7) * 16) = stg[q]; }
                        }
                        __syncthreads();
                    } else {
#pragma unroll
                        for (int j8 = 0; j8 < 8; ++j8) key[sg * 8 + j8] = 0u;
                    }
                }
                LAS unsigned* wscr = (LAS unsigned*)(lds + 81920 + wave * 1024);
                unsigned tau = 0u;
                const bool all_valid = (tq + 1) <= 256;
                bool done_sel = all_valid;
#pragma unroll 1
                for (int bit = 31; bit >= 0; --bit) {
                    const unsigned cand = tau | (1u << bit);
                    int c0 = 0, c1 = 0;
#pragma unroll
                    for (int jj = 0; jj < 64; ++jj) { const unsigned long long bm = __ballot(key[jj] >= cand); c0 += __popc((unsigned)bm); c1 += __popc((unsigned)(bm >> 32)); }
                    const int cnt = (lane < 32) ? c0 : c1;
                    if (cnt >= 256) tau = cand;
                    done_sel = done_sel || (cnt == 256);
                    if (__ballot(!done_sel) == 0ull) break;
                }
                if (all_valid) tau = 1u;
                int g0 = 0, g1 = 0, e0 = 0, e1 = 0;
#pragma unroll
                for (int jj = 0; jj < 64; ++jj) {
                    const unsigned long long bg = __ballot(key[jj] > tau), be = __ballot(key[jj] == tau);
                    g0 += __popc((unsigned)bg); g1 += __popc((unsigned)(bg >> 32)); e0 += __popc((unsigned)be); e1 += __popc((unsigned)(be >> 32));
                }
                const int cgt = (lane < 32) ? g0 : g1, ceq = (lane < 32) ? e0 : e1;
                const int need_eq = all_valid ? (1 << 20) : 256 - cgt;
                const bool ties = (!all_valid) && (ceq > need_eq);
                unsigned w0 = 0u, w1 = 0u;
                if (__ballot(ties) == 0ull) {
#pragma unroll
                    for (int jj = 0; jj < 64; ++jj) {
                        const unsigned long long bm = __ballot(key[jj] >= tau);
                        if (lane == 0) { wscr[jj] = (unsigned)bm; wscr[64 + jj] = (unsigned)(bm >> 32); }
                    }
                } else {
                    int running = 0;
#pragma unroll
                    for (int jj = 0; jj < 64; ++jj) {
                        const bool e = key[jj] == tau;
                        const unsigned long long be = __ballot(e);
                        const unsigned hb = (unsigned)(be >> (32 * qs));
                        const int rank = running + __popc(hb & ((1u << (lane & 31)) - 1u));
                        running += __popc(hb);
                        const bool sel = (key[jj] > tau) || (e && rank < need_eq);
                        const unsigned long long bm = __ballot(sel);
                        if (lane == 0) { wscr[jj] = (unsigned)bm; wscr[64 + jj] = (unsigned)(bm >> 32); }
                    }
                }
                asm volatile("s_waitcnt lgkmcnt(0)" ::: "memory");
                w0 = wscr[lane]; w1 = wscr[64 + lane];
                MASKW[tok0 * 64 + lane] = w0; MASKW[(tok0 + 1) * 64 + lane] = w1;
                asm volatile("s_waitcnt lgkmcnt(0)" ::: "memory");
            }
            }
#endif
            GSYNC();
            { PH_VARS
            ATT_REP
            for (int ub = blockIdx.x; ub < 512; ub += GRID_BLOCKS) {
                const int pass = ub >> 8, idx = ub & 255, b = idx & 7, i = idx >> 3;
                const int qt = pass ? i : 63 - i, q0 = qt * 32, h = wave * 2;
                f32x16 o[2][2]; float mm[2], ll[2];
                attn_block<64, 64, 1, false, 64, 2>(lds, QSP + ((size_t)(b * S_ + q0) * 16 + h) * 64, 1024, 64, KSP + (size_t)b * S_ * 64, 64, VTSP + (size_t)b * 64 * 2048, 2048,
                                      qt + 1, qt + 1, q0, MASKW + (size_t)(b * S_ + q0) * 64, 0.f, o, mm, ll, tid);
                store_ot<64>(o[0], 1.0f / ll[0], MIX + (size_t)(b * S_ + q0 + r32) * 1024 + h * 64, hi);
                store_ot<64>(o[1], 1.0f / ll[1], MIX + (size_t)(b * S_ + q0 + r32) * 1024 + (h + 1) * 64, hi);
            }
            }
            GSYNC();
            { KA_DEF pg8::EpiResid E{X, X, XB, SSQ, 1.0f}; run_gemm(TIDX, lds, MIX, Wl + WO_WOUT, T_, 1024, 1024, E); }
            GSYNC();
        }
        { KA_DEF pg8::EpiBf16S E{RA, 1024, SSQ}; run_gemm(TIDX, lds, XB, Wl + WO_XQ, T_, 1024, 1024, E); }
        GSYNC();
        { PH_VARS
        ATT_REP
        for (int ub = blockIdx.x; ub < 512; ub += GRID_BLOCKS) {
            const int half = ub & 1, h = (ub >> 1) & 3, qblk = ub >> 3, b = qblk >> 3;
            const int tok0 = qblk * 256 + wave * 32;
            f32x16 o[1][4]; float mm[1], ll[1];
            const size_t kvb = (size_t)((l * 8 + b) * 4 + h) * 256;
            attn_block<256, 128, 2, true, 32, 1>(lds, RA + (size_t)tok0 * 1024 + h * 256, 1024, 0, KX + kvb * 256, 256, VTX + (kvb + half * 128) * 256, 256,
                                          8, 8, 0, nullptr, 0.0625f * LOG2E, o, mm, ll, tid);
            store_ot<128>(o[0], 1.0f / ll[0], OX + (size_t)(tok0 + r32) * 1024 + h * 256 + half * 128, hi);
        }
        }
        GSYNC();
        { KA_DEF pg8::EpiResid E{X, X, XB, SSQ, 1.0f}; run_gemm(TIDX, lds, OX, Wl + WO_XO, T_, 1024, 1024, E); }
        GSYNC();
        { KA_DEF pg8::EpiSwiGLU E{RA, FF, SSQ}; run_gemm(TIDX, lds, XB, Wl + WO_13B, T_, 2 * FF, 1024, E); }
        GSYNC();
        { KA_DEF pg8::EpiResid E{X, X, XB, SSQ, 0.5f}; run_gemm(TIDX, lds, RA, Wl + WO_2B, T_, 1024, FF, E); }
        if (l + 1 < NL) GSYNC();
    }
}

extern "C" void kernel_launch(void* const* d_in, const int* in_sizes, int n_in, void* d_out, int out_size, void* d_ws, size_t ws_size, hipStream_t stream) {
    static int grid = 0;
    if (grid == 0) {
        if (n_in != 31 || out_size != T_ * DM || ws_size < WS_END) { fprintf(stderr, "kernel_launch: unexpected shapes (n_in %d out %d ws %zu)\n", n_in, out_size, ws_size); grid = -1; return; }
        int dev = 0, cus = 0, per_cu = 0;
        hipGetDevice(&dev);
        hipDeviceGetAttribute(&cus, hipDeviceAttributeMultiprocessorCount, dev);
        if (hipFuncSetAttribute((const void*)mega_fwd, hipFuncAttributeMaxDynamicSharedMemorySize, LDS_BYTES) != hipSuccess) fprintf(stderr, "kernel_launch: hipFuncSetAttribute failed\n");
        if (hipOccupancyMaxActiveBlocksPerMultiprocessor(&per_cu, (const void*)mega_fwd, 512, LDS_BYTES) != hipSuccess || per_cu < 1) { fprintf(stderr, "kernel_launch: occupancy query says %d\n", per_cu); per_cu = 1; }
        (void)hipGetLastError();
        if (cus * per_cu < GRID_BLOCKS) fprintf(stderr, "kernel_launch: device holds %d co-resident workgroups, kernel is built for %d\n", cus * per_cu, GRID_BLOCKS);
        grid = GRID_BLOCKS;
    }
    if (grid < 0) return;
    if (hipMemsetAsync((char*)d_ws + WS_CTL, 0, 16384, stream) != hipSuccess) { fprintf(stderr, "kernel_launch: memset failed\n"); return; }
    KArgs a{};
    for (int i = 0; i < 31; ++i) a.in[i] = d_in[i];
    a.out = (float*)d_out; a.ws = (unsigned char*)d_ws;
    void* args[] = {&a};
    hipError_t e = hipLaunchCooperativeKernel((const void*)mega_fwd, dim3(grid), dim3(512), args, LDS_BYTES, stream);
    if (e != hipSuccess) fprintf(stderr, "kernel_launch: cooperative launch failed: %s (grid %d)\n", hipGetErrorString(e), grid);
}
```

```cpp
#include <hip/hip_runtime.h>
#include <hip/hip_cooperative_groups.h>
#include <cstdio>
#include <cstdint>
namespace cg = cooperative_groups;
namespace pg8 {
#define PG8_LAS __attribute__((address_space(3)))
typedef unsigned short bf16_t;
typedef short bf16x8 __attribute__((ext_vector_type(8)));
typedef float f32x4 __attribute__((ext_vector_type(4)));
typedef unsigned u32x4 __attribute__((ext_vector_type(4)));
constexpr int BM = 256, BK = 64, HALF = 128, HTB = HALF * BK * 2  , STAGE_BYTES = 8 * HTB, NXCD = 8, WGM = 4;

__host__ __device__ __forceinline__ int lds_byte(int r, int c) { const int st = (r >> 4) * 2 + (c >> 5), rr = r & 15, cc = c & 31, ob = rr * 64 + cc * 2; return st * 1024 + (ob ^ (((ob >> 9) & 1) << 5)); }
__host__ __device__ __forceinline__ void stage_rc(int b, int& R, int& C) { const int st = b / 1024, sb = b % 1024, swz = sb ^ (((sb >> 9) & 1) << 5); R = (st >> 1) * 16 + swz / 64; C = (st & 1) * 32 + (swz % 64) / 2; }
__host__ __device__ __forceinline__ int perm32(int rho) { const int n = rho >> 4, i = rho & 15; return 8 * (i >> 2) + 4 * n + (i & 3); }

struct Unit { int pm, pn; };
struct Gemm { const bf16_t* A; const bf16_t* Bt; int M, N, K, tid; };

struct StaticOrder {
    int nM, nN, nwg, G, c;
    __host__ __device__ void init(int M, int N, int G_, int c_) { nM = M / BM; nN = N / BM; nwg = nM * nN; G = G_; c = c_; }
    __host__ __device__ bool next(int i, Unit& u) const {
        const long L = (long)i * G + c; if (L >= nwg) return false;
        int wgid = (int)L; { const int q = nwg / NXCD, r = nwg % NXCD, xcd = wgid % NXCD, off = wgid / NXCD; wgid = (xcd < r ? xcd * (q + 1) : r * (q + 1) + (xcd - r) * q) + off; }
        const int nig = WGM * nN, gid = wgid / nig, fm = gid * WGM, gsz = (nM - fm) < WGM ? (nM - fm) : WGM;
        u.pm = fm + ((wgid % nig) % gsz); u.pn = (wgid % nig) / gsz; return true;
    }
    __device__ __forceinline__ void a_ready(const Unit&) const {}
    __device__ __forceinline__ void done(const Unit&) const {}
};

__device__ __forceinline__ unsigned cvt_pk_bf16(float lo, float hi) { unsigned r; asm volatile("v_cvt_pk_bf16_f32 %0, %1, %2" : "=v"(r) : "v"(lo), "v"(hi)); return r; }
template <class Epi, class Sched, bool ALIGN_EPI = false, bool SP2 = false>
__device__ __forceinline__ void gemm_phase(PG8_LAS unsigned char* lds, const Gemm g, const Sched& S, const Epi& E) {
    int tid_ = g.tid; asm volatile("" : "+v"(tid_));
    const int tid = tid_, wid = __builtin_amdgcn_readfirstlane(tid >> 6), lane = tid & 63, wr = wid >> 2, wc = wid & 3, fr = lane & 15, fq = lane >> 4;
    const int K = g.K, nt = K / BK;
    unsigned voffA[2], voffB[2];
#pragma unroll
    for (int i = 0; i < 2; ++i) { int R, C; stage_rc(tid * 16 + i * 8192, R, C); const int Rb = Epi::PERM ? ((R & ~31) + perm32(R & 31)) : R;
        voffA[i] = (unsigned)(R * K + C) * 2u; voffB[i] = (unsigned)(Rb * K + C) * 2u; }
    const size_t kstep = (size_t)(BK * 2);
    const size_t hstep = (size_t)HALF * K * 2;
    const size_t tstep = 2 * hstep;
    const unsigned ldsw = (unsigned)wid * 1024u;
    const int aoff = lds_byte(wr * 64 + fr, fq * 8), boff = lds_byte(wc * 32 + fr, fq * 8);
#define PG8_SA(b, h) (((b) * 2 + (h)) * HTB)
#define PG8_SB(b, h) ((4 + (b) * 2 + (h)) * HTB)
#define PG8_STAGE(bufoff, gbase, voff) do { _Pragma("unroll") for (int _i = 0; _i < 2; ++_i) \
        __builtin_amdgcn_global_load_lds((const unsigned*)((const char*)(gbase) + (voff)[_i]), (PG8_LAS unsigned*)(lds + (bufoff) + ldsw + _i * 8192), 16, 0, 0); } while (0)
#define PG8_LDA(dst, b, h) do { _Pragma("unroll") for (int m = 0; m < 4; ++m) _Pragma("unroll") for (int k = 0; k < 2; ++k) dst[m][k] = *(const PG8_LAS bf16x8*)(lds + PG8_SA(b, h) + aoff + m * 2048 + k * 1024); } while (0)
#define PG8_LDB(dst, b, h) do { _Pragma("unroll") for (int n = 0; n < 2; ++n) _Pragma("unroll") for (int k = 0; k < 2; ++k) dst[n][k] = *(const PG8_LAS bf16x8*)(lds + PG8_SB(b, h) + boff + n * 2048 + k * 1024); } while (0)
#define PG8_MMA(ai, bj, At, Bt) do { __builtin_amdgcn_s_setprio(1); _Pragma("unroll") for (int m = 0; m < 4; ++m) _Pragma("unroll") for (int n = 0; n < 2; ++n) _Pragma("unroll") for (int k = 0; k < 2; ++k) \
        acc[ai][bj][m][n] = __builtin_amdgcn_mfma_f32_16x16x32_bf16(Bt[n][k], At[m][k], acc[ai][bj][m][n], 0, 0, 0); __builtin_amdgcn_s_setprio(0); } while (0)
#define PG8_WAIT_V(n) asm volatile("s_waitcnt vmcnt(" #n ")" ::: "memory")
#define PG8_WAIT_L(n) asm volatile("s_waitcnt lgkmcnt(" #n ")" ::: "memory")
#define PG8_BAR __builtin_amdgcn_s_barrier()
#define PG8_SCHED __builtin_amdgcn_sched_barrier(0)
    Unit cur, nxt; int ui = 0;
    if (!S.next(0, cur)) return;
    f32x4 acc[2][2][4][2];
#pragma unroll
    for (int a = 0; a < 2; ++a)
#pragma unroll
        for (int b = 0; b < 2; ++b)
#pragma unroll
            for (int m = 0; m < 4; ++m)
#pragma unroll
                for (int n = 0; n < 2; ++n) acc[a][b][m][n] = (f32x4){0.f, 0.f, 0.f, 0.f};
    bf16x8 At[4][2], B0[2][2], B1[2][2];
    const char* cA = (const char*)g.A + (size_t)cur.pm * tstep; const char* cB = (const char*)g.Bt + (size_t)cur.pn * tstep;
    S.a_ready(cur);
    if constexpr (SP2) {
        PG8_STAGE(PG8_SB(0, 0), cB, voffB); PG8_STAGE(PG8_SB(0, 1), cB + hstep, voffB); PG8_STAGE(PG8_SA(0, 0), cA, voffA); PG8_STAGE(PG8_SA(0, 1), cA + hstep, voffA);
        if (wr == 1) PG8_BAR;
        PG8_WAIT_V(2); PG8_BAR;
        PG8_STAGE(PG8_SB(1, 0), cB + kstep, voffB); PG8_STAGE(PG8_SA(1, 0), cA + kstep, voffA); PG8_STAGE(PG8_SB(1, 1), cB + hstep + kstep, voffB);
        PG8_WAIT_V(6); PG8_BAR;
    } else {
        PG8_STAGE(PG8_SB(0, 0), cB, voffB); PG8_STAGE(PG8_SA(0, 0), cA, voffA); PG8_STAGE(PG8_SB(0, 1), cB + hstep, voffB); PG8_STAGE(PG8_SA(0, 1), cA + hstep, voffA);
        if (wr == 1) PG8_BAR;
        PG8_WAIT_V(4); PG8_BAR;
        PG8_STAGE(PG8_SB(1, 0), cB + kstep, voffB); PG8_STAGE(PG8_SA(1, 0), cA + kstep, voffA); PG8_STAGE(PG8_SB(1, 1), cB + hstep + kstep, voffB);
        PG8_WAIT_V(6); PG8_BAR;
    }
    for (;;) {
        const bool has_next = S.next(ui + 1, nxt);
        const char* nA = has_next ? (const char*)g.A + (size_t)nxt.pm * tstep : cA; const char* nB = has_next ? (const char*)g.Bt + (size_t)nxt.pn * tstep : cB;
        for (int t = 0; t < nt; t += 2) {
            const bool last = (t == nt - 2);
            const char* a1 = cA + (size_t)(t + 1) * kstep;
            const char* a2 = last ? nA : cA + (size_t)(t + 2) * kstep; const char* b2 = last ? nB : cB + (size_t)(t + 2) * kstep;
            const char* a3 = a2 + kstep; const char* b3 = b2 + kstep;
            if (last && has_next) S.a_ready(nxt);
            if constexpr (SP2) {
            PG8_LDB(B0, 0, 0); PG8_LDB(B1, 0, 1); PG8_SCHED; PG8_LDA(At, 0, 0); PG8_STAGE(PG8_SA(1, 1), a1 + hstep, voffA);
            PG8_WAIT_V(8); PG8_WAIT_L(0); PG8_BAR; PG8_MMA(0, 0, At, B0); PG8_MMA(0, 1, At, B1); PG8_BAR; PG8_SCHED;
            PG8_LDA(At, 0, 1); PG8_STAGE(PG8_SB(0, 0), b2, voffB); PG8_STAGE(PG8_SB(0, 1), b2 + hstep, voffB); PG8_STAGE(PG8_SA(0, 0), a2, voffA);
            PG8_WAIT_V(8); PG8_WAIT_L(0); PG8_BAR; PG8_MMA(1, 0, At, B0); PG8_MMA(1, 1, At, B1); PG8_BAR; PG8_SCHED;
            PG8_LDB(B0, 1, 0); PG8_LDB(B1, 1, 1); PG8_SCHED; PG8_LDA(At, 1, 0); PG8_STAGE(PG8_SA(0, 1), a2 + hstep, voffA);
            PG8_WAIT_V(8); PG8_WAIT_L(0); PG8_BAR; PG8_MMA(0, 0, At, B0); PG8_MMA(0, 1, At, B1); PG8_BAR; PG8_SCHED;
            PG8_LDA(At, 1, 1); PG8_STAGE(PG8_SB(1, 0), b3, voffB); PG8_STAGE(PG8_SB(1, 1), b3 + hstep, voffB); PG8_STAGE(PG8_SA(1, 0), a3, voffA);
            PG8_WAIT_V(8); PG8_WAIT_L(0); PG8_BAR; PG8_MMA(1, 0, At, B0); PG8_MMA(1, 1, At, B1); PG8_BAR; PG8_SCHED;
            } else {
            PG8_LDB(B0, 0, 0); PG8_SCHED; PG8_LDA(At, 0, 0); PG8_STAGE(PG8_SA(1, 1), a1 + hstep, voffA);
            PG8_WAIT_L(8); PG8_BAR; PG8_WAIT_L(0); PG8_MMA(0, 0, At, B0); PG8_BAR; PG8_SCHED;
            PG8_LDB(B1, 0, 1); PG8_STAGE(PG8_SB(0, 0), b2, voffB);
            PG8_BAR; PG8_WAIT_L(0); PG8_MMA(0, 1, At, B1); PG8_BAR;
            PG8_LDA(At, 0, 1); PG8_STAGE(PG8_SA(0, 0), a2, voffA);
            PG8_BAR; PG8_WAIT_L(0); PG8_MMA(1, 0, At, B0); PG8_BAR; PG8_SCHED;
            PG8_STAGE(PG8_SB(0, 1), b2 + hstep, voffB);
            PG8_WAIT_V(6); PG8_BAR; PG8_MMA(1, 1, At, B1); PG8_BAR;
            PG8_LDB(B0, 1, 0); PG8_SCHED; PG8_LDA(At, 1, 0); PG8_STAGE(PG8_SA(0, 1), a2 + hstep, voffA);
            PG8_WAIT_L(8); PG8_BAR; PG8_WAIT_L(0); PG8_MMA(0, 0, At, B0); PG8_BAR; PG8_SCHED;
            PG8_LDB(B1, 1, 1); PG8_STAGE(PG8_SB(1, 0), b3, voffB);
            PG8_BAR; PG8_WAIT_L(0); PG8_MMA(0, 1, At, B1); PG8_BAR;
            PG8_LDA(At, 1, 1); PG8_STAGE(PG8_SA(1, 0), a3, voffA);
            PG8_BAR; PG8_WAIT_L(0); PG8_MMA(1, 0, At, B0); PG8_BAR; PG8_SCHED;
            PG8_STAGE(PG8_SB(1, 1), b3 + hstep, voffB);
            PG8_WAIT_V(6); PG8_BAR; PG8_MMA(1, 1, At, B1); PG8_BAR;
            }
        }
        if constexpr (ALIGN_EPI) { if (wr == 0) PG8_BAR; }
        if constexpr (!Epi::AFTER_DRAIN) { E(acc, cur, wr, wc, fr, fq); S.done(cur); }
        if (!has_next) break;
#pragma unroll
        for (int a = 0; a < 2; ++a)
#pragma unroll
            for (int b = 0; b < 2; ++b)
#pragma unroll
                for (int m = 0; m < 4; ++m)
#pragma unroll
                    for (int n = 0; n < 2; ++n) acc[a][b][m][n] = (f32x4){0.f, 0.f, 0.f, 0.f};
        cur = nxt; cA = nA; cB = nB; ++ui;
        if constexpr (ALIGN_EPI) { if (wr == 1) PG8_BAR; }
    }
    PG8_WAIT_V(0);
    if constexpr (!ALIGN_EPI) { if (wr == 0) PG8_BAR; }
    PG8_BAR;
    if constexpr (Epi::AFTER_DRAIN) { E.fused(acc, cur, wr, wc, fr, fq, lds, wid, lane); S.done(cur); }
#undef PG8_SA
#undef PG8_SB
#undef PG8_STAGE
#undef PG8_LDA
#undef PG8_LDB
#undef PG8_MMA
#undef PG8_WAIT_V
#undef PG8_WAIT_L
#undef PG8_BAR
#undef PG8_SCHED
}
}

#define LAS __attribute__((address_space(3)))
typedef unsigned short bf16_t;
typedef short bf16x8 __attribute__((ext_vector_type(8)));
typedef float f32x4 __attribute__((ext_vector_type(4)));
typedef float f32x16 __attribute__((ext_vector_type(16)));
typedef unsigned u32x4 __attribute__((ext_vector_type(4)));
typedef unsigned u32x2 __attribute__((ext_vector_type(2)));
typedef float f32x2 __attribute__((ext_vector_type(2)));

constexpr int T_ = 16384, S_ = 2048, NBATCH = 8, DM = 1024, FF = 2816, MEMLEN = 256, NL = 4;
constexpr int EVEN_IN = 2720, EVEN_INP = 2816, ODD_IN = 1736, ODD_INP = 1792;
constexpr float EPS = 1e-6f, LOG2E = 1.4426950408889634f;
constexpr int LDS_BYTES = 147456;
constexpr int BIGW = 1 << 30;
constexpr int GRID_BLOCKS = 256;

constexpr size_t MiB = 1u << 20;
constexpr size_t WS_W = 0, WS_XKV = 48 * MiB, WS_KX = 64 * MiB, WS_VTX = 80 * MiB, WS_XB = 96 * MiB, WS_SSQ = 128 * MiB, WS_MEMB = 129 * MiB,
                 WS_MEMSSQ = 133 * MiB, WS_CS64 = 134 * MiB, WS_CS32 = 138 * MiB, WS_A = 140 * MiB, WS_B = 228 * MiB, WS_CTL = 377 * MiB, WS_END = 378 * MiB;
constexpr size_t WO_13A = 0, WO_2A = WO_13A + (size_t)5632 * 1024, WO_13B = WO_2A + (size_t)1024 * 2816, WO_2B = WO_13B + (size_t)5632 * 1024,
                 WO_XQ = WO_2B + (size_t)1024 * 2816, WO_XO = WO_XQ + (size_t)1024 * 1024, WO_WIN = WO_XO + (size_t)1024 * 1024,
                 WO_BD = WO_WIN + (size_t)2816 * 1024, WO_WOUT = WO_BD + (size_t)1792 * 384, WO_END = WO_WOUT + (size_t)1024 * 1024;
static_assert(WO_END * 2 <= 48 * MiB, "weights region");
constexpr size_t B_QD = 0, B_KD = 24 * MiB, B_VTD = 48 * MiB, B_QM = 72 * MiB, B_KM = 96 * MiB, B_VTM = 120 * MiB, B_CQKV = 136 * MiB, B_KROPE = 148 * MiB;
constexpr size_t B_QSP = 0, B_QI = 32 * MiB, B_KSP = 48 * MiB, B_VTSP = 50 * MiB, B_KI = 52 * MiB, B_WI = 54 * MiB, B_MASKW = 55 * MiB;
constexpr size_t B_KVRAW = 0;
constexpr size_t A_MIX = 0, A_ODIL = 24 * MiB, A_LSE = 48 * MiB, A_OX = 32 * MiB;

__device__ __forceinline__ unsigned f2bf(float f) { unsigned u = __float_as_uint(f); return (u + 0x7fffu + ((u >> 16) & 1u)) >> 16; }
__device__ __forceinline__ float bf2f(unsigned h) { return __uint_as_float(h << 16); }
__device__ __forceinline__ unsigned pk2(float lo, float hi) { return f2bf(lo) | (f2bf(hi) << 16); }
__device__ __forceinline__ float wave_sum(float v) {
#pragma unroll
    for (int o = 1; o < 64; o <<= 1) v += __shfl_xor(v, o);
    return v;
}
template <int N> __device__ __forceinline__ void wave_sum_n(float (&v)[N]) {
#pragma unroll
    for (int o = 1; o < 64; o <<= 1) {
#pragma unroll
        for (int i = 0; i < N; ++i) v[i] += __shfl_xor(v[i], o);
    }
}
__device__ __forceinline__ float row_rstd16(const float* ssq, int row, float inv_n) {
    const f32x4* p = (const f32x4*)(ssq + (size_t)row * 16);
    const f32x4 a = p[0], b = p[1], c = p[2], d = p[3];
    const float s = ((a[0] + a[1]) + (a[2] + a[3])) + ((b[0] + b[1]) + (b[2] + b[3])) + ((c[0] + c[1]) + (c[2] + c[3])) + ((d[0] + d[1]) + (d[2] + d[3]));
    return __builtin_amdgcn_rsqf(s * inv_n + EPS);
}

__device__ __forceinline__ float row_rstd16_coop(const float* ssq, int row, int fq, float inv_n) {
    const f32x4 a = *(const f32x4*)(ssq + (size_t)row * 16 + fq * 4);
    float s = (a[0] + a[1]) + (a[2] + a[3]);
    s += __shfl_xor(s, 16); s += __shfl_xor(s, 32);
    return __builtin_amdgcn_rsqf(s * inv_n + EPS);
}
namespace pg8 {
struct EpiBf16S {
    static constexpr bool PERM = true, AFTER_DRAIN = false; static constexpr int EID = 0;
    bf16_t* O; int ldc; const float* ssq;
    __device__ __forceinline__ void operator()(const f32x4 (&acc)[2][2][4][2], const Unit& u, int wr, int wc, int fr, int fq) const {
        const int row0 = u.pm * BM + wr * 64 + fr, col0 = u.pn * BM + wc * 32 + 8 * fq;
        float rsv[2][4];
#pragma unroll
        for (int ai = 0; ai < 2; ++ai) {
#pragma unroll
            for (int m = 0; m < 4; ++m) rsv[ai][m] = ssq ? row_rstd16_coop(ssq, row0 + ai * HALF + m * 16, fq, 1.0f / 1024.0f) : 1.0f;
        }
#pragma unroll
        for (int ai = 0; ai < 2; ++ai)
#pragma unroll
            for (int m = 0; m < 4; ++m) {
                const int row = row0 + ai * HALF + m * 16;
                const float rs = rsv[ai][m];
                bf16_t* rowp = O + (size_t)row * ldc + col0;
#pragma unroll
                for (int bj = 0; bj < 2; ++bj) {
                    const f32x4 v0 = acc[ai][bj][m][0] * rs, v1 = acc[ai][bj][m][1] * rs;
                    u32x4 w; w.x = cvt_pk_bf16(v0[0], v0[1]); w.y = cvt_pk_bf16(v0[2], v0[3]); w.z = cvt_pk_bf16(v1[0], v1[1]); w.w = cvt_pk_bf16(v1[2], v1[3]);
                    *(u32x4*)(rowp + bj * HALF) = w;
                }
            }
    }
};
struct EpiSwiGLU {
    static constexpr bool PERM = true, AFTER_DRAIN = false; static constexpr int EID = 1;
    bf16_t* H; int ldh; const float* ssq;
    __device__ __forceinline__ static float sg(float g, float uu) { return g * __builtin_amdgcn_rcpf(1.0f + __builtin_amdgcn_exp2f(-1.4426950408889634f * g)) * uu; }
    __device__ __forceinline__ void operator()(const f32x4 (&acc)[2][2][4][2], const Unit& u, int wr, int wc, int fr, int fq) const {
        const int row0 = u.pm * BM + wr * 64 + fr, col0 = u.pn * BM + wc * 32 + 8 * fq;
        float rsv[2][4];
#pragma unroll
        for (int ai = 0; ai < 2; ++ai) {
#pragma unroll
            for (int m = 0; m < 4; ++m) rsv[ai][m] = row_rstd16_coop(ssq, row0 + ai * HALF + m * 16, fq, 1.0f / 1024.0f);
        }
#pragma unroll
        for (int ai = 0; ai < 2; ++ai)
#pragma unroll
            for (int m = 0; m < 4; ++m) {
                const int row = row0 + ai * HALF + m * 16;
                const float rs = rsv[ai][m];
                bf16_t* rowp = H + (size_t)row * ldh + (col0 >> 1);
#pragma unroll
                for (int bj = 0; bj < 2; ++bj) {
                    const f32x4 v0 = acc[ai][bj][m][0] * rs, v1 = acc[ai][bj][m][1] * rs;
                    u32x2 w; w.x = cvt_pk_bf16(sg(v0[0], v0[1]), sg(v0[2], v0[3])); w.y = cvt_pk_bf16(sg(v1[0], v1[1]), sg(v1[2], v1[3]));
                    *(u32x2*)(rowp + bj * (HALF / 2)) = w;
                }
            }
    }
};
struct EpiResid {
    static constexpr bool PERM = true, AFTER_DRAIN = false; static constexpr int EID = 2;
    const float* Xin; float* X; bf16_t* XB; float* ssq; float scale;
    __device__ __forceinline__ void operator()(const f32x4 (&acc)[2][2][4][2], const Unit& u, int wr, int wc, int fr, int fq) const {
        const int row0 = u.pm * BM + wr * 64 + fr, col0 = u.pn * BM + wc * 32 + 8 * fq;
        f32x4 xv[2][2][2][2];
#define RESID_LOAD(buf, g) do { _Pragma("unroll") for (int rr_ = 0; rr_ < 2; ++rr_) { const int idx_ = 2 * (g) + rr_; const int row_ = row0 + (idx_ >> 2) * HALF + (idx_ & 3) * 16; \
            _Pragma("unroll") for (int bj_ = 0; bj_ < 2; ++bj_) { const f32x4* p_ = (const f32x4*)(Xin + (size_t)row_ * 1024 + col0 + bj_ * HALF); xv[buf][rr_][bj_][0] = p_[0]; xv[buf][rr_][bj_][1] = p_[1]; } } } while (0)
        RESID_LOAD(0, 0);
#pragma unroll
        for (int g = 0; g < 4; ++g) {
            if (g < 3) RESID_LOAD((g + 1) & 1, g + 1);
#pragma unroll
            for (int rr = 0; rr < 2; ++rr) {
                const int idx = 2 * g + rr, ai = idx >> 2, m = idx & 3;
                const int row = row0 + ai * HALF + m * 16;
                float* xr = X + (size_t)row * 1024 + col0; bf16_t* br = XB + (size_t)row * 1024 + col0;
                float ss = 0.f;
#pragma unroll
                for (int bj = 0; bj < 2; ++bj) {
                    f32x4* p = (f32x4*)(xr + bj * HALF);
                    const f32x4 o0 = xv[g & 1][rr][bj][0] + acc[ai][bj][m][0] * scale, o1 = xv[g & 1][rr][bj][1] + acc[ai][bj][m][1] * scale;
                    p[0] = o0; p[1] = o1;
                    u32x4 w; w.x = cvt_pk_bf16(o0[0], o0[1]); w.y = cvt_pk_bf16(o0[2], o0[3]); w.z = cvt_pk_bf16(o1[0], o1[1]); w.w = cvt_pk_bf16(o1[2], o1[3]);
                    *(u32x4*)(br + bj * HALF) = w;
                    ss += (o0[0] * o0[0] + o0[1] * o0[1]) + (o0[2] * o0[2] + o0[3] * o0[3]) + (o1[0] * o1[0] + o1[1] * o1[1]) + (o1[2] * o1[2] + o1[3] * o1[3]);
                }
                ss += __shfl_xor(ss, 16); ss += __shfl_xor(ss, 32);
                if (fq == 0) ssq[(size_t)row * 16 + u.pn * 4 + wc] = ss;
            }
            asm volatile("" ::: "memory");
        }
#undef RESID_LOAD
    }
};
}

template <class Epi> __device__ __forceinline__ void run_gemm(const int tid, LAS unsigned char* lds, const bf16_t* A, const bf16_t* Bt, int M, int N, int K, const Epi& E) {
    asm volatile("" : "+s"(M), "+s"(N), "+s"(K)); asm volatile("" : "+s"(A), "+s"(Bt));
    pg8::Gemm g{A, Bt, M, N, K, tid}; pg8::StaticOrder S; S.init(M, N, (int)gridDim.x, (int)blockIdx.x);
#ifndef SKIP_GEMM
#ifdef REP_GEMM
    { Epi E0 = E; if constexpr (Epi::EID == 2) E0.scale = 0.f; pg8::gemm_phase<Epi, pg8::StaticOrder, true, true>(lds, g, S, E0); }
#endif
    pg8::gemm_phase<Epi, pg8::StaticOrder, true, true>(lds, g, S, E);
#endif
}

__device__ __forceinline__ void conv_item(const float* __restrict__ W, const float* __restrict__ g, int K, int NS, int NP, bf16_t* __restrict__ dst, int ldd, int koff, int row_off, int ilv,
                                          LAS float* scr, int item, int lane) {
    (void)K;
    LAS unsigned char* tile = (LAS unsigned char*)scr;
    const int nblk = (NP + 127) / 128, kb = item / nblk, nb = item % nblk, k0 = 64 * kb, n0 = 128 * nb, n = n0 + lane * 2;
    const bool rd = (W != nullptr) && (n < NS);
#pragma unroll 1
    for (int b2 = 0; b2 < 2; ++b2) {
        f32x2 v[32];
#pragma unroll
        for (int r = 0; r < 32; ++r) {
            const int k = k0 + b2 * 32 + r;
            v[r] = rd ? __builtin_nontemporal_load((const f32x2*)(W + (size_t)k * NS + n)) : (f32x2){0.f, 0.f};
        }
        if (g != nullptr) {
#pragma unroll
            for (int r = 0; r < 32; ++r) v[r] = v[r] * g[k0 + b2 * 32 + r];
        }
#pragma unroll
        for (int i = 0; i < 2; ++i) {
            const int nl = lane * 2 + i;
#pragma unroll
            for (int h = 0; h < 4; ++h) {
                u32x4 o; o.x = pk2(v[h * 8 + 0][i], v[h * 8 + 1][i]); o.y = pk2(v[h * 8 + 2][i], v[h * 8 + 3][i]); o.z = pk2(v[h * 8 + 4][i], v[h * 8 + 5][i]); o.w = pk2(v[h * 8 + 6][i], v[h * 8 + 7][i]);
                *(LAS u32x4*)(tile + nl * 128 + (((b2 * 4 + h) ^ (lane & 7)) << 4)) = o;
            }
        }
    }
    asm volatile("s_waitcnt lgkmcnt(0)" ::: "memory");
#pragma unroll
    for (int j = 0; j < 16; ++j) {
        const int idx = j * 64 + lane, nl = idx >> 3, q = idx & 7, nn = n0 + nl;
        const u32x4 o = *(const LAS u32x4*)(tile + nl * 128 + ((q ^ ((nl >> 1) & 7)) << 4));
        if (nn < NP) {
            const int drow = row_off + (ilv ? (nn < ilv ? 2 * nn : 2 * (nn - ilv) + 1) : nn);
            *(u32x4*)(dst + (size_t)drow * ldd + koff + k0 + q * 8) = o;
        }
    }
    asm volatile("s_waitcnt lgkmcnt(0)" ::: "memory");
}

__device__ __forceinline__ int crow(int r, int hi) { return (r & 3) + 8 * (r >> 2) + 4 * hi; }

template <int DQK, int DV, int MODE, bool QNORM, bool PF>
__device__ __forceinline__ void attn_tile(const bf16_t* __restrict__ Qp, int q_pitch, const bf16_t* __restrict__ Kp, int k_pitch,
                                          const bf16_t* __restrict__ Vt, int vt_pitch, int kt_lo, int kt_hi, int q0, int qoff, int W,
                                          const unsigned* __restrict__ mw, float qk_scale, f32x16 (&o)[DV / 32], float& m_out, float& l_out, const int lane) {
    const int r32 = lane & 31, hi = lane >> 5;
    bf16x8 qf[DQK / 16];
#pragma unroll
    for (int d0 = 0; d0 < DQK / 16; ++d0) qf[d0] = *(const bf16x8*)(Qp + (size_t)r32 * q_pitch + d0 * 16 + hi * 8);
    float sscale = 1.0f;
    if (QNORM) {
        float ss = 0.f;
#pragma unroll
        for (int d0 = 0; d0 < DQK / 16; ++d0)
#pragma unroll
            for (int j = 0; j < 8; ++j) { const float v = bf2f((unsigned)(unsigned short)qf[d0][j]); ss += v * v; }
        ss += __shfl_xor(ss, 32);
        sscale = qk_scale * __builtin_amdgcn_rsqf(ss * (1.0f / DQK) + EPS);
    }
    float m_run = 0.f, l_run = 0.f;
#pragma unroll
    for (int dt = 0; dt < DV / 32; ++dt)
#pragma unroll
        for (int r = 0; r < 16; ++r) o[dt][r] = 0.f;
    const bf16_t* kbase = Kp + (size_t)r32 * k_pitch + hi * 8;
    const bf16_t* vbase = Vt + (size_t)r32 * vt_pitch + hi * 8;
    const unsigned* mbase = (MODE == 1) ? (mw + (size_t)r32 * 64) : nullptr;
    bf16x8 kf[DQK / 16], vf[DV / 32][2]; unsigned w = 0xffffffffu;
#define ATT_LOAD(KF, VF, WW, kt_) do { const bf16_t* kb_ = kbase + (size_t)(kt_) * 32 * k_pitch; \
        _Pragma("unroll") for (int d0 = 0; d0 < DQK / 16; ++d0) KF[d0] = *(const bf16x8*)(kb_ + d0 * 16); \
        _Pragma("unroll") for (int dt = 0; dt < DV / 32; ++dt) _Pragma("unroll") for (int ks = 0; ks < 2; ++ks) VF[dt][ks] = *(const bf16x8*)(vbase + (size_t)dt * 32 * vt_pitch + (kt_) * 32 + ks * 16); \
        if (MODE == 1) WW = mbase[kt_]; } while (0)
    if (PF) { if (kt_lo < kt_hi) ATT_LOAD(kf, vf, w, kt_lo); }
    for (int kt = kt_lo; kt < kt_hi; ++kt) {
        bf16x8 kfn[PF ? DQK / 16 : 1], vfn[PF ? DV / 32 : 1][2]; unsigned wn = 0xffffffffu;
        if (PF) { if (kt + 1 < kt_hi) ATT_LOAD(kfn, vfn, wn, kt + 1); }
        else ATT_LOAD(kf, vf, w, kt);
        f32x16 s;
#pragma unroll
        for (int r = 0; r < 16; ++r) s[r] = 0.f;
#pragma unroll
        for (int d0 = 0; d0 < DQK / 16; ++d0) s = __builtin_amdgcn_mfma_f32_32x32x16_bf16(kf[d0], qf[d0], s, 0, 0, 0);
#pragma unroll
        for (int r = 0; r < 16; ++r) s[r] = QNORM ? (s[r] * sscale - m_run) : (s[r] - m_run);
        if (MODE == 0) {
            const int dmax = q0 + 31 + qoff - kt * 32, dmin = q0 + qoff - kt * 32 - 31;
            if (!(dmin >= 0 && dmax <= W)) {
#pragma unroll
                for (int r = 0; r < 16; ++r) { const int d = q0 + r32 + qoff - (kt * 32 + crow(r, hi)); if ((unsigned)d > (unsigned)W) s[r] = -INFINITY; }
            }
        } else {
#pragma unroll
            for (int r = 0; r < 16; ++r) { if (((w >> crow(r, hi)) & 1u) == 0u) s[r] = -INFINITY; }
        }
        float tm = s[0];
#pragma unroll
        for (int r = 1; r < 16; ++r) tm = fmaxf(tm, s[r]);
        tm = fmaxf(tm, __shfl_xor(tm, 32));
        if (__ballot(tm > 0.f) != 0ull) {
            const float dl = fmaxf(tm, 0.f); m_run += dl;
            const float alpha = __builtin_amdgcn_exp2f(-dl);
            l_run *= alpha;
#pragma unroll
            for (int r = 0; r < 16; ++r) s[r] -= dl;
#pragma unroll
            for (int dt = 0; dt < DV / 32; ++dt)
#pragma unroll
                for (int r = 0; r < 16; ++r) o[dt][r] *= alpha;
        }
        float ps = 0.f;
#pragma unroll
        for (int r = 0; r < 16; ++r) { s[r] = __builtin_amdgcn_exp2f(s[r]); ps += s[r]; }
        l_run += ps;
        u32x4 p0, p1;
        p0.x = pg8::cvt_pk_bf16(s[0], s[1]); p0.y = pg8::cvt_pk_bf16(s[2], s[3]); p0.z = pg8::cvt_pk_bf16(s[4], s[5]); p0.w = pg8::cvt_pk_bf16(s[6], s[7]);
        p1.x = pg8::cvt_pk_bf16(s[8], s[9]); p1.y = pg8::cvt_pk_bf16(s[10], s[11]); p1.z = pg8::cvt_pk_bf16(s[12], s[13]); p1.w = pg8::cvt_pk_bf16(s[14], s[15]);
        const bf16x8 pf0 = __builtin_bit_cast(bf16x8, p0), pf1 = __builtin_bit_cast(bf16x8, p1);
#pragma unroll
        for (int dt = 0; dt < DV / 32; ++dt) {
            o[dt] = __builtin_amdgcn_mfma_f32_32x32x16_bf16(vf[dt][0], pf0, o[dt], 0, 0, 0);
            o[dt] = __builtin_amdgcn_mfma_f32_32x32x16_bf16(vf[dt][1], pf1, o[dt], 0, 0, 0);
        }
        if (PF) {
#pragma unroll
            for (int d0 = 0; d0 < DQK / 16; ++d0) kf[d0] = kfn[PF ? d0 : 0];
#pragma unroll
            for (int dt = 0; dt < DV / 32; ++dt) { vf[dt][0] = vfn[PF ? dt : 0][0]; vf[dt][1] = vfn[PF ? dt : 0][1]; }
            w = wn;
        }
    }
#undef ATT_LOAD
    l_run += __shfl_xor(l_run, 32);
    m_out = m_run; l_out = l_run;
}
template <int DQK, int DV, int MODE, bool QNORM, int SK, int NQ>
__device__ __forceinline__ void attn_block(LAS unsigned char* lds, const bf16_t* __restrict__ Qp, int q_pitch, int q_hoff, const bf16_t* __restrict__ Kp, int k_pitch,
                                           const bf16_t* __restrict__ Vt, int vt_pitch, int nst, int nst_w, int q0, const unsigned* __restrict__ mw, float qk_scale,
                                           f32x16 (&o)[NQ][DV / 32], float (&m_out)[NQ], float (&l_out)[NQ], const int tid) {
    constexpr int NSUB = SK / 32, KP = DQK * 2 + 16, VP = SK * 2 + 16, KBYTES = SK * KP, VBYTES = DV * VP, STAGE = KBYTES + VBYTES;
    constexpr int KCPR = DQK / 8, VCPR = SK / 8, KCH = SK * KCPR, VCH = DV * VCPR, NCH = KCH + VCH, NLD = (NCH + 511) / 512;
    static_assert(2 * STAGE <= 131072, "attention stages fit the ring region");
    const int lane = tid & 63, r32 = lane & 31, hi = lane >> 5;
    bf16x8 qf[NQ][DQK / 16];
#pragma unroll
    for (int qh = 0; qh < NQ; ++qh)
#pragma unroll
        for (int d0 = 0; d0 < DQK / 16; ++d0) qf[qh][d0] = *(const bf16x8*)(Qp + (size_t)qh * q_hoff + (size_t)r32 * q_pitch + d0 * 16 + hi * 8);
    float sscale[NQ];
#pragma unroll
    for (int qh = 0; qh < NQ; ++qh) {
        sscale[qh] = 1.0f;
        if (QNORM) {
            float ss = 0.f;
#pragma unroll
            for (int d0 = 0; d0 < DQK / 16; ++d0)
#pragma unroll
                for (int jq = 0; jq < 8; ++jq) { const float v = bf2f((unsigned)(unsigned short)qf[qh][d0][jq]); ss += v * v; }
            ss += __shfl_xor(ss, 32);
            sscale[qh] = qk_scale * __builtin_amdgcn_rsqf(ss * (1.0f / DQK) + EPS);
        }
    }
    float m_run[NQ], l_run[NQ];
#pragma unroll
    for (int qh = 0; qh < NQ; ++qh) {
        m_run[qh] = 0.f; l_run[qh] = 0.f;
#pragma unroll
        for (int dt = 0; dt < DV / 32; ++dt)
#pragma unroll
            for (int r = 0; r < 16; ++r) o[qh][dt][r] = 0.f;
    }
    int goff[NLD]; bool isk[NLD]; int gstep[NLD]; int ldst[NLD]; bool act[NLD];
#pragma unroll
    for (int i = 0; i < NLD; ++i) {
        const int c = tid + i * 512; act[i] = c < NCH;
        isk[i] = c < KCH;
        if (c < KCH) { const int row = c / KCPR, ch = c % KCPR; goff[i] = row * k_pitch + ch * 8; gstep[i] = SK * k_pitch; ldst[i] = row * KP + ch * 16; }
        else { const int c2 = c - KCH, row = c2 / VCPR, ch = c2 % VCPR; goff[i] = (row < DV ? row : 0) * vt_pitch + ch * 8; gstep[i] = SK; ldst[i] = KBYTES + row * VP + ch * 16; }
    }
    constexpr bool PF2 = (NQ == 1 && DQK <= 96);
    u32x4 stg[NLD], stg2[NLD];
    const int nstage = (nst + NSUB - 1) / NSUB;
#pragma unroll
    for (int i = 0; i < NLD; ++i) if (act[i]) stg2[i] = *(const u32x4*)((isk[i] ? Kp : Vt) + goff[i]);
    if (PF2 && 1 < nstage) {
#pragma unroll
        for (int i = 0; i < NLD; ++i) if (act[i]) stg[i] = *(const u32x4*)((isk[i] ? Kp : Vt) + goff[i] + gstep[i]);
    }
#pragma unroll
    for (int i = 0; i < NLD; ++i) if (act[i]) *(LAS u32x4*)(lds + ldst[i]) = stg2[i];
    unsigned wcur0 = 0xffffffffu, wcur1 = 0xffffffffu;
    const unsigned* mrow = (MODE == 1) ? (mw + (size_t)r32 * 64) : nullptr;
    if (MODE == 1) { wcur0 = mrow[0]; wcur1 = (NSUB > 1 && 1 < nst) ? mrow[1] : 0u; }
    __syncthreads();
    for (int sg = 0; sg < nstage; ++sg) {
        const bool more = sg + 1 < nstage;
        unsigned wn0 = 0xffffffffu, wn1 = 0xffffffffu;
        if (PF2) {
            if (sg + 2 < nstage) {
#pragma unroll
                for (int i = 0; i < NLD; ++i) if (act[i]) stg2[i] = *(const u32x4*)((isk[i] ? Kp : Vt) + goff[i] + (sg + 2) * gstep[i]);
            }
        } else if (more) {
#pragma unroll
            for (int i = 0; i < NLD; ++i) if (act[i]) stg[i] = *(const u32x4*)((isk[i] ? Kp : Vt) + goff[i] + (sg + 1) * gstep[i]);
        }
        if (more) {
            if (MODE == 1) { wn0 = mrow[NSUB * sg + NSUB]; wn1 = (NSUB > 1 && NSUB * sg + NSUB + 1 < nst) ? mrow[NSUB * sg + NSUB + 1] : 0u; }
        }
        LAS unsigned char* sb = lds + (sg & 1) * STAGE;
        if (NSUB * sg < nst_w) {
            f32x16 sc[NQ][NSUB];
#pragma unroll
            for (int qh = 0; qh < NQ; ++qh)
#pragma unroll
                for (int sub = 0; sub < NSUB; ++sub)
#pragma unroll
                    for (int r = 0; r < 16; ++r) sc[qh][sub][r] = QNORM ? 0.f : -m_run[qh];
            if (NQ == 1 && DQK <= 96) {
                bf16x8 kfa[NSUB][DQK / 16];
#pragma unroll
                for (int d0 = 0; d0 < DQK / 16; ++d0)
#pragma unroll
                    for (int sub = 0; sub < NSUB; ++sub) kfa[sub][d0] = *(const LAS bf16x8*)(sb + (sub * 32 + r32) * KP + hi * 16 + d0 * 32);
                asm volatile("s_waitcnt lgkmcnt(0)" ::: "memory");
                __builtin_amdgcn_sched_barrier(0);
                __builtin_amdgcn_s_setprio(1);
#pragma unroll
                for (int d0 = 0; d0 < DQK / 16; ++d0)
#pragma unroll
                    for (int sub = 0; sub < NSUB; ++sub) sc[0][sub] = __builtin_amdgcn_mfma_f32_32x32x16_bf16(kfa[sub][d0], qf[0][d0], sc[0][sub], 0, 0, 0);
            } else {
            __builtin_amdgcn_s_setprio(1);
#pragma unroll
            for (int d0 = 0; d0 < DQK / 16; ++d0)
#pragma unroll
                for (int sub = 0; sub < NSUB; ++sub) {
                    const bf16x8 kf = *(const LAS bf16x8*)(sb + (sub * 32 + r32) * KP + hi * 16 + d0 * 32);
#pragma unroll
                    for (int qh = 0; qh < NQ; ++qh) sc[qh][sub] = __builtin_amdgcn_mfma_f32_32x32x16_bf16(kf, qf[qh][d0], sc[qh][sub], 0, 0, 0);
                }
            }
            __builtin_amdgcn_s_setprio(0);
#pragma unroll
            for (int sub = 0; sub < NSUB; ++sub) {
                const int st = NSUB * sg + sub;
                if (QNORM) {
#pragma unroll
                    for (int qh = 0; qh < NQ; ++qh)
#pragma unroll
                        for (int r = 0; r < 16; ++r) sc[qh][sub][r] = sc[qh][sub][r] * sscale[qh] - m_run[qh];
                }
                if (MODE == 0) {
                    if (st * 32 + 31 > q0) {
#pragma unroll
                        for (int r = 0; r < 16; ++r) { if (st * 32 + crow(r, hi) > q0 + r32) {
#pragma unroll
                            for (int qh = 0; qh < NQ; ++qh) sc[qh][sub][r] = -INFINITY; } }
                    }
                } else if (MODE == 1) {
                    const unsigned w = sub ? wcur1 : wcur0;
#pragma unroll
                    for (int r = 0; r < 16; ++r) { if (((w >> crow(r, hi)) & 1u) == 0u) {
#pragma unroll
                        for (int qh = 0; qh < NQ; ++qh) sc[qh][sub][r] = -INFINITY; } }
                } else if (st >= nst_w) {
#pragma unroll
                    for (int qh = 0; qh < NQ; ++qh)
#pragma unroll
                        for (int r = 0; r < 16; ++r) sc[qh][sub][r] = -INFINITY;
                }
            }
            bf16x8 pf[NQ][NSUB][2];
#pragma unroll
            for (int qh = 0; qh < NQ; ++qh) {
                float tm = sc[qh][0][0];
#pragma unroll
                for (int sub = 0; sub < NSUB; ++sub)
#pragma unroll
                    for (int r = 0; r < 16; ++r) tm = fmaxf(tm, sc[qh][sub][r]);
                tm = fmaxf(tm, __shfl_xor(tm, 32));
                if (__ballot(tm > 0.f) != 0ull) {
                    const float dl = fmaxf(tm, 0.f); m_run[qh] += dl;
                    const float alpha = __builtin_amdgcn_exp2f(-dl);
                    l_run[qh] *= alpha;
#pragma unroll
                    for (int sub = 0; sub < NSUB; ++sub)
#pragma unroll
                        for (int r = 0; r < 16; ++r) sc[qh][sub][r] -= dl;
#pragma unroll
                    for (int dt = 0; dt < DV / 32; ++dt)
#pragma unroll
                        for (int r = 0; r < 16; ++r) o[qh][dt][r] *= alpha;
                }
                float ps = 0.f;
#pragma unroll
                for (int sub = 0; sub < NSUB; ++sub)
#pragma unroll
                    for (int r = 0; r < 16; ++r) { sc[qh][sub][r] = __builtin_amdgcn_exp2f(sc[qh][sub][r]); ps += sc[qh][sub][r]; }
                l_run[qh] += ps;
#pragma unroll
                for (int sub = 0; sub < NSUB; ++sub) {
                    u32x4 p0, p1;
                    p0.x = pg8::cvt_pk_bf16(sc[qh][sub][0], sc[qh][sub][1]); p0.y = pg8::cvt_pk_bf16(sc[qh][sub][2], sc[qh][sub][3]); p0.z = pg8::cvt_pk_bf16(sc[qh][sub][4], sc[qh][sub][5]); p0.w = pg8::cvt_pk_bf16(sc[qh][sub][6], sc[qh][sub][7]);
                    p1.x = pg8::cvt_pk_bf16(sc[qh][sub][8], sc[qh][sub][9]); p1.y = pg8::cvt_pk_bf16(sc[qh][sub][10], sc[qh][sub][11]); p1.z = pg8::cvt_pk_bf16(sc[qh][sub][12], sc[qh][sub][13]); p1.w = pg8::cvt_pk_bf16(sc[qh][sub][14], sc[qh][sub][15]);
                    pf[qh][sub][0] = __builtin_bit_cast(bf16x8, p0); pf[qh][sub][1] = __builtin_bit_cast(bf16x8, p1);
                }
            }
            __builtin_amdgcn_s_setprio(1);
#pragma unroll
            for (int sub = 0; sub < NSUB; ++sub) {
                const LAS unsigned char* vb = sb + KBYTES + r32 * VP + (sub * 32 + hi * 8) * 2;
#pragma unroll
                for (int dt = 0; dt < DV / 32; ++dt) {
                    const bf16x8 v0 = *(const LAS bf16x8*)(vb + dt * 32 * VP), v1 = *(const LAS bf16x8*)(vb + dt * 32 * VP + 32);
#pragma unroll
                    for (int qh = 0; qh < NQ; ++qh) {
                        o[qh][dt] = __builtin_amdgcn_mfma_f32_32x32x16_bf16(v0, pf[qh][sub][0], o[qh][dt], 0, 0, 0);
                        o[qh][dt] = __builtin_amdgcn_mfma_f32_32x32x16_bf16(v1, pf[qh][sub][1], o[qh][dt], 0, 0, 0);
                    }
                }
            }
            __builtin_amdgcn_s_setprio(0);
        }
        if (more) {
            LAS unsigned char* nb = lds + ((sg + 1) & 1) * STAGE;
#pragma unroll
            for (int i = 0; i < NLD; ++i) if (act[i]) *(LAS u32x4*)(nb + ldst[i]) = stg[i];
            if (PF2) {
#pragma unroll
                for (int i = 0; i < NLD; ++i) stg[i] = stg2[i];
            }
            wcur0 = wn0; wcur1 = wn1;
        }
        __syncthreads();
    }
#pragma unroll
    for (int qh = 0; qh < NQ; ++qh) { l_run[qh] += __shfl_xor(l_run[qh], 32); m_out[qh] = m_run[qh]; l_out[qh] = l_run[qh]; }
}
template <int DV> __device__ __forceinline__ void store_ot(const f32x16 (&o)[DV / 32], float inv_l, bf16_t* orow, int hi) {
#pragma unroll
    for (int dt = 0; dt < DV / 32; ++dt)
#pragma unroll
        for (int a = 0; a < 4; ++a) {
            u32x2 w; w.x = pk2(o[dt][4 * a] * inv_l, o[dt][4 * a + 1] * inv_l); w.y = pk2(o[dt][4 * a + 2] * inv_l, o[dt][4 * a + 3] * inv_l);
            *(u32x2*)(orow + dt * 32 + 8 * a + 4 * hi) = w;
        }
}

template <int DIL> __device__ __forceinline__ void vt_item(const bf16_t* __restrict__ src, size_t src_pitch, bf16_t* __restrict__ dstrow, int s0, int L, int lane) {
    unsigned v[64];
#pragma unroll
    for (int i = 0; i < 64; ++i) v[i] = src[(size_t)i * src_pitch + lane];
    const int mb = s0 / DIL;
#pragma unroll
    for (int r = 0; r < DIL; ++r)
#pragma unroll
        for (int q4 = 0; q4 < 16 / DIL; ++q4) {
            const int m_base = mb + 4 * q4, pidx = r * L + m_base, a = (m_base >> 2) & 3, slot = 8 * (a & 1) + 4 * (a >> 1);
            u32x2 w; w.x = v[(4 * q4 + 0) * DIL + r] | (v[(4 * q4 + 1) * DIL + r] << 16); w.y = v[(4 * q4 + 2) * DIL + r] | (v[(4 * q4 + 3) * DIL + r] << 16);
            *(u32x2*)(dstrow + (pidx & ~15) + slot) = w;
        }
}

template <int D> __device__ __forceinline__ void head_vec(const bf16_t* __restrict__ src, const float* __restrict__ g0, const float* __restrict__ g1, bool sel1, bool norm, bool rope,
                                                          float scale, const f32x2* __restrict__ cs, bf16_t* __restrict__ dst) {
    float v[D];
#pragma unroll
    for (int q = 0; q < D / 8; ++q) {
        const u32x4 raw = *(const u32x4*)(src + 8 * q);
        v[8 * q + 0] = bf2f(raw.x & 0xffffu); v[8 * q + 1] = bf2f(raw.x >> 16); v[8 * q + 2] = bf2f(raw.y & 0xffffu); v[8 * q + 3] = bf2f(raw.y >> 16);
        v[8 * q + 4] = bf2f(raw.z & 0xffffu); v[8 * q + 5] = bf2f(raw.z >> 16); v[8 * q + 6] = bf2f(raw.w & 0xffffu); v[8 * q + 7] = bf2f(raw.w >> 16);
    }
    float ss = 0.f;
#pragma unroll
    for (int d = 0; d < D; ++d) ss += v[d] * v[d];
    const float rs = norm ? __builtin_amdgcn_rsqf(ss * (1.0f / D) + EPS) : 1.0f;
#pragma unroll
    for (int d = 0; d < D; ++d) { const float gg = norm ? (sel1 ? g1[d] : g0[d]) : 1.0f; v[d] = v[d] * rs * gg; }
#pragma unroll
    for (int i = 0; i < D / 4; ++i) {
        const f32x4 c2 = *(const f32x4*)(cs + 2 * i);
#pragma unroll
        for (int e = 0; e < 2; ++e) {
            const int d = 2 * i + e; const float cc = rope ? c2[2 * e] : 1.0f, sn = rope ? c2[2 * e + 1] : 0.0f;
            const float a = v[d], b = v[d + D / 2];
            v[d] = (a * cc - b * sn) * scale; v[d + D / 2] = (b * cc + a * sn) * scale;
        }
    }
#pragma unroll
    for (int q = 0; q < D / 8; ++q) {
        u32x4 w; w.x = pg8::cvt_pk_bf16(v[8 * q], v[8 * q + 1]); w.y = pg8::cvt_pk_bf16(v[8 * q + 2], v[8 * q + 3]); w.z = pg8::cvt_pk_bf16(v[8 * q + 4], v[8 * q + 5]); w.w = pg8::cvt_pk_bf16(v[8 * q + 6], v[8 * q + 7]);
        *(u32x4*)(dst + 8 * q) = w;
    }
}

template <int D> __device__ __forceinline__ void head_vec8(const bf16_t* __restrict__ src, const float* __restrict__ gain, bool norm, bool rope, float scale,
                                                           const f32x2* __restrict__ cs, bf16_t* __restrict__ dst, const int sub) {
    constexpr int NH = D / 16;
    float lo[NH], hi[NH];
    if (NH == 4) {
        const u32x2 a = *(const u32x2*)(src + sub * 4), b = *(const u32x2*)(src + D / 2 + sub * 4);
        lo[0] = bf2f(a.x & 0xffffu); lo[1] = bf2f(a.x >> 16); lo[NH - 2] = bf2f(a.y & 0xffffu); lo[NH - 1] = bf2f(a.y >> 16);
        hi[0] = bf2f(b.x & 0xffffu); hi[1] = bf2f(b.x >> 16); hi[NH - 2] = bf2f(b.y & 0xffffu); hi[NH - 1] = bf2f(b.y >> 16);
    } else {
        const unsigned a = *(const unsigned*)(src + sub * 2), b = *(const unsigned*)(src + D / 2 + sub * 2);
        lo[0] = bf2f(a & 0xffffu); lo[1] = bf2f(a >> 16); hi[0] = bf2f(b & 0xffffu); hi[1] = bf2f(b >> 16);
    }
    float ss = 0.f;
#pragma unroll
    for (int i = 0; i < NH; ++i) ss += lo[i] * lo[i] + hi[i] * hi[i];
    ss += __shfl_xor(ss, 1); ss += __shfl_xor(ss, 2); ss += __shfl_xor(ss, 4);
    const float rs = norm ? __builtin_amdgcn_rsqf(ss * (1.0f / D) + EPS) : 1.0f;
    float cc[NH], sn[NH];
    if (NH == 4) {
        const f32x4 g0 = *(const f32x4*)(gain + sub * 4), g1 = *(const f32x4*)(gain + D / 2 + sub * 4);
        const f32x4 c0 = *(const f32x4*)(cs + sub * 4), c1 = *(const f32x4*)(cs + sub * 4 + 2);
#pragma unroll
        for (int i = 0; i < 4; ++i) { lo[i] *= norm ? rs * g0[i] : 1.0f; hi[i] *= norm ? rs * g1[i] : 1.0f; }
        cc[0] = c0[0]; sn[0] = c0[1]; cc[1] = c0[2]; sn[1] = c0[3]; cc[NH - 2] = c1[0]; sn[NH - 2] = c1[1]; cc[NH - 1] = c1[2]; sn[NH - 1] = c1[3];
    } else {
        const f32x2 g0 = *(const f32x2*)(gain + sub * 2), g1 = *(const f32x2*)(gain + D / 2 + sub * 2);
        const f32x4 c0 = *(const f32x4*)(cs + sub * 2);
#pragma unroll
        for (int i = 0; i < 2; ++i) { lo[i] *= norm ? rs * g0[i] : 1.0f; hi[i] *= norm ? rs * g1[i] : 1.0f; }
        cc[0] = c0[0]; sn[0] = c0[1]; cc[1] = c0[2]; sn[1] = c0[3];
    }
    float ol[NH], oh[NH];
#pragma unroll
    for (int i = 0; i < NH; ++i) {
        const float c = rope ? cc[i] : 1.0f, sv = rope ? sn[i] : 0.0f;
        ol[i] = (lo[i] * c - hi[i] * sv) * scale; oh[i] = (hi[i] * c + lo[i] * sv) * scale;
    }
    if (NH == 4) {
        u32x2 w0, w1; w0.x = pg8::cvt_pk_bf16(ol[0], ol[1]); w0.y = pg8::cvt_pk_bf16(ol[NH - 2], ol[NH - 1]); w1.x = pg8::cvt_pk_bf16(oh[0], oh[1]); w1.y = pg8::cvt_pk_bf16(oh[NH - 2], oh[NH - 1]);
        *(u32x2*)(dst + sub * 4) = w0; *(u32x2*)(dst + D / 2 + sub * 4) = w1;
    } else {
        *(unsigned*)(dst + sub * 2) = pg8::cvt_pk_bf16(ol[0], ol[1]); *(unsigned*)(dst + D / 2 + sub * 2) = pg8::cvt_pk_bf16(oh[0], oh[1]);
    }
}

struct HVRaw { u32x2 a, b; f32x4 g0, g1, c0, c1; };
template <int D> __device__ __forceinline__ void hv_load(HVRaw& r, const bf16_t* __restrict__ src, const float* __restrict__ gain, const f32x2* __restrict__ cs, const int sub) {
    if (D == 64) {
        r.a = *(const u32x2*)(src + sub * 4); r.b = *(const u32x2*)(src + 32 + sub * 4);
        r.g0 = *(const f32x4*)(gain + sub * 4); r.g1 = *(const f32x4*)(gain + 32 + sub * 4);
        r.c0 = *(const f32x4*)(cs + sub * 4); r.c1 = *(const f32x4*)(cs + sub * 4 + 2);
    } else {
        r.a.x = *(const unsigned*)(src + sub * 2); r.b.x = *(const unsigned*)(src + 16 + sub * 2); r.a.y = 0u; r.b.y = 0u;
        const f32x2 g0 = *(const f32x2*)(gain + sub * 2), g1 = *(const f32x2*)(gain + 16 + sub * 2);
        r.g0 = (f32x4){g0.x, g0.y, 0.f, 0.f}; r.g1 = (f32x4){g1.x, g1.y, 0.f, 0.f};
        r.c0 = *(const f32x4*)(cs + sub * 2); r.c1 = r.c0;
    }
}
template <int D> __device__ __forceinline__ void hv_finish(const HVRaw& r, bool norm, bool rope, float scale, bf16_t* __restrict__ dst, const int sub) {
    constexpr int NH = D / 16;
    float lo[4], hi[4], cc[4], sn[4];
    lo[0] = bf2f(r.a.x & 0xffffu); lo[1] = bf2f(r.a.x >> 16); lo[2] = bf2f(r.a.y & 0xffffu); lo[3] = bf2f(r.a.y >> 16);
    hi[0] = bf2f(r.b.x & 0xffffu); hi[1] = bf2f(r.b.x >> 16); hi[2] = bf2f(r.b.y & 0xffffu); hi[3] = bf2f(r.b.y >> 16);
    float ss = 0.f;
#pragma unroll
    for (int i = 0; i < NH; ++i) ss += lo[i] * lo[i] + hi[i] * hi[i];
    ss += __shfl_xor(ss, 1); ss += __shfl_xor(ss, 2); ss += __shfl_xor(ss, 4);
    const float rs = norm ? __builtin_amdgcn_rsqf(ss * (1.0f / D) + EPS) : 1.0f;
#pragma unroll
    for (int i = 0; i < NH; ++i) { lo[i] *= norm ? rs * r.g0[i] : 1.0f; hi[i] *= norm ? rs * r.g1[i] : 1.0f; }
    cc[0] = r.c0[0]; sn[0] = r.c0[1]; cc[1] = r.c0[2]; sn[1] = r.c0[3]; cc[2] = r.c1[0]; sn[2] = r.c1[1]; cc[3] = r.c1[2]; sn[3] = r.c1[3];
    float ol[4], oh[4];
#pragma unroll
    for (int i = 0; i < NH; ++i) {
        const float c = rope ? cc[i] : 1.0f, sv = rope ? sn[i] : 0.0f;
        ol[i] = (lo[i] * c - hi[i] * sv) * scale; oh[i] = (hi[i] * c + lo[i] * sv) * scale;
    }
    if (NH == 4) {
        u32x2 w0, w1; w0.x = pg8::cvt_pk_bf16(ol[0], ol[1]); w0.y = pg8::cvt_pk_bf16(ol[2], ol[3]); w1.x = pg8::cvt_pk_bf16(oh[0], oh[1]); w1.y = pg8::cvt_pk_bf16(oh[2], oh[3]);
        *(u32x2*)(dst + sub * 4) = w0; *(u32x2*)(dst + 32 + sub * 4) = w1;
    } else {
        *(unsigned*)(dst + sub * 2) = pg8::cvt_pk_bf16(ol[0], ol[1]); *(unsigned*)(dst + 16 + sub * 2) = pg8::cvt_pk_bf16(oh[0], oh[1]);
    }
}

template <int D> __device__ __forceinline__ void norm_vec(const bf16_t* __restrict__ src, const float* __restrict__ gain, bf16_t* __restrict__ dst, const int sub) {
    const u32x4 raw = *(const u32x4*)(src + sub * 8);
    float v[8];
    v[0] = bf2f(raw.x & 0xffffu); v[1] = bf2f(raw.x >> 16); v[2] = bf2f(raw.y & 0xffffu); v[3] = bf2f(raw.y >> 16);
    v[4] = bf2f(raw.z & 0xffffu); v[5] = bf2f(raw.z >> 16); v[6] = bf2f(raw.w & 0xffffu); v[7] = bf2f(raw.w >> 16);
    float ss = 0.f;
#pragma unroll
    for (int i = 0; i < 8; ++i) ss += v[i] * v[i];
#pragma unroll
    for (int o = 1; o < D / 8; o <<= 1) ss += __shfl_xor(ss, o);
    const float rs = __builtin_amdgcn_rsqf(ss * (1.0f / D) + EPS);
    const f32x4 g0 = *(const f32x4*)(gain + sub * 8), g1 = *(const f32x4*)(gain + sub * 8 + 4);
    u32x4 w; w.x = pg8::cvt_pk_bf16(v[0] * rs * g0[0], v[1] * rs * g0[1]); w.y = pg8::cvt_pk_bf16(v[2] * rs * g0[2], v[3] * rs * g0[3]);
    w.z = pg8::cvt_pk_bf16(v[4] * rs * g1[0], v[5] * rs * g1[1]); w.w = pg8::cvt_pk_bf16(v[6] * rs * g1[2], v[7] * rs * g1[3]);
    *(u32x4*)(dst + sub * 8) = w;
}

__device__ __forceinline__ float rope_apply(float y, float partner, f32x2 cs, bool first_half) { return first_half ? y * cs.x - partner * cs.y : y * cs.x + partner * cs.y; }

#define XB_TMO      128
#define XB_XCNT(j)  (256  + 64 * (j))
#define XB_XSUB(j)  (1280 + 64 * (j))
#define XB_XGEN(j)  (2304 + 64 * (j))
#define XB_TOP      3328
#define XB_TOPGEN   3392
#define XCD_BAR_WORDS 3456
#define XB_SPIN_CAP (1u << 18)

__device__ __forceinline__ unsigned xb_ld(unsigned* p)              { return __hip_atomic_load(p, __ATOMIC_RELAXED, __HIP_MEMORY_SCOPE_AGENT); }
__device__ __forceinline__ unsigned xb_add(unsigned* p, unsigned v) { return __hip_atomic_fetch_add(p, v, __ATOMIC_RELAXED, __HIP_MEMORY_SCOPE_AGENT); }
__device__ __forceinline__ unsigned xb_xcc_id() { return (unsigned)__builtin_amdgcn_s_getreg((3 << 11) | 20) & 0xFu; }
#define XB_SPIN(cond, bar) do { unsigned _sp = 0; while (cond) { __builtin_amdgcn_s_sleep(1); \
    if ((++_sp & 255u) == 0u) { if (xb_ld(&(bar)[XB_TMO])) break; if (_sp > XB_SPIN_CAP) { atomicAdd(&(bar)[XB_TMO], 1u); break; } } } } while (0)

struct XcdBarrier {
    unsigned* bar; unsigned x; unsigned tid;
    volatile LAS unsigned* st;
};

__device__ __forceinline__ XcdBarrier xcd_barrier_post(unsigned* bar, volatile LAS unsigned* st) {
    XcdBarrier b; b.bar = bar; b.x = xb_xcc_id(); b.st = st; b.tid = threadIdx.x;
    if (threadIdx.x == 0) (void)xb_add(&bar[XB_XCNT(b.x)], 1u);
    return b;
}
__device__ __forceinline__ void xcd_barrier_complete(unsigned* bar, unsigned x, unsigned& nloc, unsigned& nx) {
    const unsigned G = gridDim.x * gridDim.y * gridDim.z;
    unsigned sum, cnt, mine, sp = 0u;
    for (;;) {
        sum = 0u; cnt = 0u; mine = 0u;
#pragma unroll
        for (unsigned j = 0; j < 16; ++j) { const unsigned c = xb_ld(&bar[XB_XCNT(j)]); sum += c; cnt += (c > 0u) ? 1u : 0u; mine = (j == x) ? c : mine; }
        if (sum == G) break;
        __builtin_amdgcn_s_sleep(1);
        if ((++sp & 255u) == 0u) { if (xb_ld(&bar[XB_TMO])) break; if (sp > XB_SPIN_CAP) { atomicAdd(&bar[XB_TMO], 1u); break; } }
    }
    nloc = mine > 0u ? mine : 1u; nx = cnt > 0u ? cnt : 1u;
}

__device__ __forceinline__ void xcd_barrier(const XcdBarrier& b) {
    asm volatile("s_waitcnt vmcnt(0)" ::: "memory");
    __syncthreads();
    if (b.tid == 0u) {
        unsigned* bar = b.bar;
        __builtin_amdgcn_s_waitcnt(0);
        unsigned nloc = b.st[0], nx = b.st[1];
        if (nloc == 0u) { xcd_barrier_complete(bar, b.x, nloc, nx); b.st[0] = nloc; b.st[1] = nx; }
        const unsigned old = xb_add(&bar[XB_XSUB(b.x)], 1u);
        const unsigned gen = old / nloc;
        if (old + 1u == (gen + 1u) * nloc) {
            __builtin_amdgcn_fence(__ATOMIC_RELEASE, "agent");
            asm volatile("s_waitcnt vmcnt(0)" ::: "memory");
            const unsigned og = xb_add(&bar[XB_TOP], 1u);
            const unsigned tg = og / nx;
            if (og + 1u == (tg + 1u) * nx) xb_add(&bar[XB_TOPGEN], 1u);
            else XB_SPIN(xb_ld(&bar[XB_TOPGEN]) == tg, bar);
            __builtin_amdgcn_fence(__ATOMIC_ACQUIRE, "agent");
            xb_add(&bar[XB_XGEN(b.x)], 1u);
            asm volatile("s_waitcnt vmcnt(0)" ::: "memory");
        } else {
            XB_SPIN(xb_ld(&bar[XB_XGEN(b.x)]) == gen, bar);
            __builtin_amdgcn_fence(__ATOMIC_ACQUIRE, "agent");
            asm volatile("s_waitcnt vmcnt(0)" ::: "memory");
        }
    }
    __syncthreads();
}

struct KArgs { const void* in[31]; float* out; unsigned char* ws; };

__global__ void __launch_bounds__(512, 2) mega_fwd(KArgs a) {
    extern __shared__ __attribute__((aligned(16))) unsigned char lds_raw[];
    LAS unsigned char* lds = (LAS unsigned char*)lds_raw;
    cg::grid_group grid = cg::this_grid();
    const int wave_s = __builtin_amdgcn_readfirstlane((int)(threadIdx.x >> 6));
#define TIDX (wave_s * 64 + (int)__builtin_amdgcn_mbcnt_hi(~0u, __builtin_amdgcn_mbcnt_lo(~0u, 0u)))
#ifdef REP_ATT
#define ATT_REP for (int rep_ = 0; rep_ < 2; ++rep_)
#else
#define ATT_REP
#endif
#ifdef REP_IDX
#define IDX_REP for (int rep_ = 0; rep_ < 2; ++rep_)
#else
#define IDX_REP
#endif
#ifdef REP_EWA
#define EWA_REP for (int rep_ = 0; rep_ < 2; ++rep_)
#else
#define EWA_REP
#endif
#ifdef REP_EWB
#define EWB_REP for (int rep_ = 0; rep_ < 2; ++rep_)
#else
#define EWB_REP
#endif
#define PH_VARS KA_DEF int tid = TIDX; asm volatile("" : "+v"(tid)); const int lane = tid & 63, wave = __builtin_amdgcn_readfirstlane(tid >> 6); \
    const int gw = blockIdx.x * 8 + wave; constexpr int NGW = GRID_BLOCKS * 8; const int r32 = lane & 31, hi = lane >> 5; LAS float* scr = (LAS float*)(lds + wave * 16384); \
    (void)gw; (void)NGW; (void)r32; (void)hi; (void)scr;

#define KA_DEF const __attribute__((address_space(4))) KArgs* ka_ = (const __attribute__((address_space(4))) KArgs*)__builtin_amdgcn_kernarg_segment_ptr(); asm volatile("" : "+s"(ka_));
#define KA_ ka_
#define INF(k) ((const float*)KA_->in[k])
#define x_in INF(0)
#define mem_in INF(1)
#define pos_in ((const int*)KA_->in[2])
#define ffn1_norm INF(3)
#define ffn1_w13 INF(4)
#define ffn1_w2 INF(5)
#define mix_norm INF(6)
#define xattn_norm INF(7)
#define mem_norm INF(8)
#define xattn_wq INF(9)
#define xattn_wkv INF(10)
#define xattn_qg INF(11)
#define xattn_kg INF(12)
#define xattn_wo INF(13)
#define ffn2_norm INF(14)
#define ffn2_w13 INF(15)
#define ffn2_w2 INF(16)
#define even_w_in INF(17)
#define mla_qlora_g INF(18)
#define mla_kvlora_g INF(19)
#define mla_w_uq INF(20)
#define mla_w_ukv INF(21)
#define mla_q_g INF(22)
#define mla_k_g INF(23)
#define dil_q_g INF(24)
#define dil_k_g INF(25)
#define even_w_out INF(26)
#define odd_w_in INF(27)
#define sp_q_g INF(28)
#define sp_k_g INF(29)
#define odd_w_out INF(30)
#define X (KA_->out)
#define WSP(off) (KA_->ws + (off))
#define Wl ((bf16_t*)WSP(WS_W))
#define XKV ((bf16_t*)WSP(WS_XKV))
#define KX ((bf16_t*)WSP(WS_KX))
#define VTX ((bf16_t*)WSP(WS_VTX))
#define XB ((bf16_t*)WSP(WS_XB))
#define SSQ ((float*)WSP(WS_SSQ))
#define MEMB ((bf16_t*)WSP(WS_MEMB))
#define MEMSSQ ((float*)WSP(WS_MEMSSQ))
#define CS64 ((f32x2*)WSP(WS_CS64))
#define CS32 ((f32x2*)WSP(WS_CS32))
#define RA ((bf16_t*)WSP(WS_A))
#define QD ((bf16_t*)WSP(WS_B + B_QD))
#define KD ((bf16_t*)WSP(WS_B + B_KD))
#define VTD ((bf16_t*)WSP(WS_B + B_VTD))
#define QM ((bf16_t*)WSP(WS_B + B_QM))
#define KM ((bf16_t*)WSP(WS_B + B_KM))
#define VTM ((bf16_t*)WSP(WS_B + B_VTM))
#define CQKV ((bf16_t*)WSP(WS_B + B_CQKV))
#define KROPE ((bf16_t*)WSP(WS_B + B_KROPE))
#define QSP ((bf16_t*)WSP(WS_B + B_QSP))
#define QI ((bf16_t*)WSP(WS_B + B_QI))
#define KSP ((bf16_t*)WSP(WS_B + B_KSP))
#define VTSP ((bf16_t*)WSP(WS_B + B_VTSP))
#define KI ((bf16_t*)WSP(WS_B + B_KI))
#define WI ((float*)WSP(WS_B + B_WI))
#define MASKW ((unsigned*)WSP(WS_B + B_MASKW))
#define KVRAW ((bf16_t*)WSP(WS_B + B_KVRAW))
#define MIX ((bf16_t*)WSP(WS_A + A_MIX))
#define ODIL ((bf16_t*)WSP(WS_A + A_ODIL))
#define LSE ((float*)WSP(WS_A + A_LSE))
#define OX ((bf16_t*)WSP(WS_A + A_OX))

    volatile LAS unsigned* MISC = (volatile LAS unsigned*)(lds + 131072 + 320);
    if (threadIdx.x < 32) MISC[threadIdx.x] = 0u;
    __syncthreads();
    { KA_DEF (void)xcd_barrier_post((unsigned*)WSP(WS_CTL), MISC + 8); }
#define XSYNC() do { KA_DEF XcdBarrier b_; b_.tid = (unsigned)TIDX; b_.bar = (unsigned*)WSP(WS_CTL); b_.x = xb_xcc_id(); b_.st = (volatile LAS unsigned*)(lds + 131072 + 320) + 8; xcd_barrier(b_); } while (0)
#ifdef REP_SYNC
#define GSYNC() do { XSYNC(); XSYNC(); } while (0)
#else
#define GSYNC() XSYNC()
#endif
#define CONV_JOB(Wp, Gp, KK, NS, NP, DSTP, LDD, KOFF, ROFF, ILV) { const int ni_ = ((KK) / 64) * (((NP) + 127) / 128); \
        if (r < ni_) { conv_item(Wp, Gp, KK, NS, NP, DSTP, LDD, KOFF, ROFF, ILV, scr, r, lane); continue; } r -= ni_; }
#define CONV_LAYER(l) do { const int l_ = (l), j_ = l_ >> 1; const bool ev_ = (l_ & 1) == 0; \
        for (int it = gw;; it += NGW) { int r = it; \
            CONV_JOB(ffn1_w13 + (size_t)l_ * 1024 * 5632, ffn1_norm + l_ * 1024, 1024, 5632, 5632, Wl + WO_13A, 1024, 0, 0, FF) \
            CONV_JOB(ffn1_w2 + (size_t)l_ * 2816 * 1024, (const float*)nullptr, 2816, 1024, 1024, Wl + WO_2A, 2816, 0, 0, 0) \
            CONV_JOB(ffn2_w13 + (size_t)l_ * 1024 * 5632, ffn2_norm + l_ * 1024, 1024, 5632, 5632, Wl + WO_13B, 1024, 0, 0, FF) \
            CONV_JOB(ffn2_w2 + (size_t)l_ * 2816 * 1024, (const float*)nullptr, 2816, 1024, 1024, Wl + WO_2B, 2816, 0, 0, 0) \
            CONV_JOB(xattn_wq + (size_t)l_ * 1024 * 1024, xattn_norm + l_ * 1024, 1024, 1024, 1024, Wl + WO_XQ, 1024, 0, 0, 0) \
            CONV_JOB(xattn_wo + (size_t)l_ * 1024 * 1024, (const float*)nullptr, 1024, 1024, 1024, Wl + WO_XO, 1024, 0, 0, 0) \
            if (ev_) { \
                CONV_JOB(even_w_in + (size_t)j_ * 1024 * EVEN_IN, mix_norm + l_ * 1024, 1024, EVEN_IN, EVEN_INP, Wl + WO_WIN, 1024, 0, 0, 0) \
                CONV_JOB(mla_w_uq + (size_t)j_ * 256 * 768, (const float*)nullptr, 256, 768, 768, Wl + WO_BD, 384, 0, 0, 0) \
                CONV_JOB(mla_w_ukv + (size_t)j_ * 128 * 1024, (const float*)nullptr, 128, 1024, 1024, Wl + WO_BD, 384, 256, 768, 0) \
                CONV_JOB((const float*)nullptr, (const float*)nullptr, 128, 768, 768, Wl + WO_BD, 384, 256, 0, 0) \
                CONV_JOB((const float*)nullptr, (const float*)nullptr, 256, 1024, 1024, Wl + WO_BD, 384, 0, 768, 0) \
                CONV_JOB(even_w_out + (size_t)j_ * 768 * 1024, (const float*)nullptr, 768, 1024, 1024, Wl + WO_WOUT, 768, 0, 0, 0) \
            } else { \
                CONV_JOB(odd_w_in + (size_t)j_ * 1024 * ODD_IN, mix_norm + l_ * 1024, 1024, ODD_IN, ODD_INP, Wl + WO_WIN, 1024, 0, 0, 0) \
                CONV_JOB(odd_w_out + (size_t)j_ * 1024 * 1024, (const float*)nullptr, 1024, 1024, 1024, Wl + WO_WOUT, 1024, 0, 0, 0) \
            } \
            break; } } while (0)

    { PH_VARS EWA_REP {
    CONV_LAYER(0);
    for (int it = gw;; it += NGW) { int r = it;
        CONV_JOB(xattn_wkv + (size_t)0 * 1024 * 2048, mem_norm + 0 * 1024, 1024, 2048, 2048, XKV + (size_t)0 * 2048 * 1024, 1024, 0, 0, 0)
        CONV_JOB(xattn_wkv + (size_t)1 * 1024 * 2048, mem_norm + 1 * 1024, 1024, 2048, 2048, XKV + (size_t)1 * 2048 * 1024, 1024, 0, 0, 0)
        CONV_JOB(xattn_wkv + (size_t)2 * 1024 * 2048, mem_norm + 2 * 1024, 1024, 2048, 2048, XKV + (size_t)2 * 2048 * 1024, 1024, 0, 0, 0)
        CONV_JOB(xattn_wkv + (size_t)3 * 1024 * 2048, mem_norm + 3 * 1024, 1024, 2048, 2048, XKV + (size_t)3 * 2048 * 1024, 1024, 0, 0, 0)
        break; }
    for (int m0 = gw; m0 < T_ + NBATCH * MEMLEN; m0 += 2 * NGW) {
        f32x4 v[2][4]; bool ok[2];
#pragma unroll
        for (int u2 = 0; u2 < 2; ++u2) {
            const int m = m0 + u2 * NGW; ok[u2] = m < T_ + NBATCH * MEMLEN;
            const bool is_x = m < T_; const int row = is_x ? m : m - T_;
            const f32x4* xr = (const f32x4*)((is_x ? x_in : mem_in) + (size_t)row * DM) + lane;
#pragma unroll
            for (int j = 0; j < 4; ++j) v[u2][j] = ok[u2] ? xr[64 * j] : (f32x4){0.f, 0.f, 0.f, 0.f};
        }
#pragma unroll
        for (int u2 = 0; u2 < 2; ++u2) {
            const int m = m0 + u2 * NGW;
            const bool is_x = m < T_; const int row = is_x ? m : m - T_;
            float sacc = 0.f;
#pragma unroll
            for (int j = 0; j < 4; ++j) sacc += (v[u2][j][0] * v[u2][j][0] + v[u2][j][1] * v[u2][j][1]) + (v[u2][j][2] * v[u2][j][2] + v[u2][j][3] * v[u2][j][3]);
            sacc = wave_sum(sacc);
            if (ok[u2]) {
                bf16_t* ob = (is_x ? XB : MEMB) + (size_t)row * DM; float* sq = (is_x ? SSQ : MEMSSQ) + (size_t)row * 16;
#pragma unroll
                for (int j = 0; j < 4; ++j) {
                    u32x2 w; w.x = pk2(v[u2][j][0], v[u2][j][1]); w.y = pk2(v[u2][j][2], v[u2][j][3]);
                    ((u32x2*)ob + lane)[64 * j] = w;
                }
                if (lane < 16) sq[lane] = (lane == 0) ? sacc : 0.f;
            }
        }
    }
    for (int e = blockIdx.x * 512 + tid; e < T_ * 48; e += GRID_BLOCKS * 512) {
        const int t = e / 48, c = e % 48; const bool is64 = c < 32; const int i = is64 ? c : c - 32; const int dim = is64 ? 64 : 32;
        const float ex = (-9.210340371976184f * (float)(2 * i)) / (float)dim;
        const float inv = expf(ex);
        const float ang = (float)pos_in[t] * inv;
        const double ad = (double)ang; const double kq = rint(ad * 0.6366197723675814); const double rr = ad - kq * 1.5707963267948966;
        const double r2 = rr * rr;
        const double sn = rr * (1.0 + r2 * (-1.0 / 6 + r2 * (1.0 / 120 + r2 * (-1.0 / 5040 + r2 * (1.0 / 362880 + r2 * (-1.0 / 39916800))))));
        const double cn = 1.0 + r2 * (-0.5 + r2 * (1.0 / 24 + r2 * (-1.0 / 720 + r2 * (1.0 / 40320 + r2 * (-1.0 / 3628800 + r2 * (1.0 / 479001600))))));
        const int q = ((int)kq) & 3;
        const double cc = (q == 0) ? cn : (q == 1) ? -sn : (q == 2) ? -cn : sn;
        const double sv = (q == 0) ? sn : (q == 1) ? cn : (q == 2) ? -sn : -cn;
        f32x2 o; o.x = (float)cc; o.y = (float)sv;
        if (is64) CS64[(size_t)t * 32 + i] = o; else CS32[(size_t)t * 16 + i] = o;
    }
    } }
    if (gridDim.y == 0x7fffu) grid.sync();
    GSYNC();

    { KA_DEF pg8::EpiBf16S E{KVRAW, 8192, MEMSSQ}; run_gemm(TIDX, lds, MEMB, XKV, NBATCH * MEMLEN, 8192, 1024, E); }
    GSYNC();
    { PH_VARS EWA_REP {
    for (int e = gw * 64 + lane; e < NL * 2048 * 4 * 32; e += NGW * 64) {
        const int vec = e >> 5, sub = lane & 31, h = vec & 3, row = (vec >> 2) & 2047, l = vec >> 13, b = row >> 8, m = row & 255;
        const u32x4 raw = *(const u32x4*)(KVRAW + (size_t)row * 8192 + l * 2048 + h * 256 + sub * 8);
        const f32x4 k0 = *(const f32x4*)(xattn_kg + l * 256 + sub * 8), k1 = *(const f32x4*)(xattn_kg + l * 256 + sub * 8 + 4);
        const f32x4 q0 = *(const f32x4*)(xattn_qg + l * 256 + sub * 8), q1 = *(const f32x4*)(xattn_qg + l * 256 + sub * 8 + 4);
        float v[8];
        v[0] = bf2f(raw.x & 0xffffu); v[1] = bf2f(raw.x >> 16); v[2] = bf2f(raw.y & 0xffffu); v[3] = bf2f(raw.y >> 16);
        v[4] = bf2f(raw.z & 0xffffu); v[5] = bf2f(raw.z >> 16); v[6] = bf2f(raw.w & 0xffffu); v[7] = bf2f(raw.w >> 16);
        float ss = 0.f;
#pragma unroll
        for (int i = 0; i < 8; ++i) ss += v[i] * v[i];
        ss += __shfl_xor(ss, 1); ss += __shfl_xor(ss, 2); ss += __shfl_xor(ss, 4); ss += __shfl_xor(ss, 8); ss += __shfl_xor(ss, 16);
        const float rs = __builtin_amdgcn_rsqf(ss * (1.0f / 256.0f) + EPS);
        u32x4 w; w.x = pg8::cvt_pk_bf16(v[0] * rs * k0[0] * q0[0], v[1] * rs * k0[1] * q0[1]); w.y = pg8::cvt_pk_bf16(v[2] * rs * k0[2] * q0[2], v[3] * rs * k0[3] * q0[3]);
        w.z = pg8::cvt_pk_bf16(v[4] * rs * k1[0] * q1[0], v[5] * rs * k1[1] * q1[1]); w.w = pg8::cvt_pk_bf16(v[6] * rs * k1[2] * q1[2], v[7] * rs * k1[3] * q1[3]);
        *(u32x4*)(KX + ((size_t)((l * 8 + b) * 4 + h) * 256 + m) * 256 + sub * 8) = w;
    }
    for (int it = gw; it < 2048; it += NGW) {
        const int dq = it & 3, ch = (it >> 2) & 3, h = (it >> 4) & 3, b = (it >> 6) & 7, l = it >> 9;
        const bf16_t* src = KVRAW + (size_t)(b * 256 + ch * 64) * 8192 + l * 2048 + 1024 + h * 256 + dq * 64;
        bf16_t* dst = VTX + ((size_t)((l * 8 + b) * 4 + h) * 256 + dq * 64 + lane) * 256;
        vt_item<1>(src, 8192, dst, ch * 64, 256, lane);
    }
    } }
    GSYNC();

#pragma unroll 1
    for (int l = 0; l < NL; ++l) {
        const int j = l >> 1; const bool even = (l & 1) == 0;
        if (l > 0) { { PH_VARS EWA_REP { CONV_LAYER(l); } } GSYNC(); }
        { KA_DEF pg8::EpiSwiGLU E{RA, FF, SSQ}; run_gemm(TIDX, lds, XB, Wl + WO_13A, T_, 2 * FF, 1024, E); }
        GSYNC();
        { KA_DEF pg8::EpiResid E{(l == 0) ? x_in : (const float*)X, X, XB, SSQ, 0.5f}; run_gemm(TIDX, lds, RA, Wl + WO_2A, T_, 1024, FF, E); }
        GSYNC();
        const int ldc = even ? EVEN_INP : ODD_INP;
        { KA_DEF pg8::EpiBf16S E{RA, ldc, SSQ}; run_gemm(TIDX, lds, XB, Wl + WO_WIN, T_, ldc, 1024, E); }
        GSYNC();
        if (even) {
            { PH_VARS EWB_REP {
            const float* qlg = mla_qlora_g + j * 256; const float* kvlg = mla_kvlora_g + j * 128; const float* mkg = mla_k_g + j * 96;
            const float* dqg = dil_q_g + j * 64; const float* dkg = dil_k_g + j * 64;
            for (int e = gw * 64 + lane; e < T_ * 32; e += NGW * 64) {
                const int t = e >> 5;
                norm_vec<256>(RA + (size_t)t * EVEN_INP, qlg, CQKV + (size_t)t * 384, lane & 31);
            }
            for (int e = gw * 64 + lane; e < T_ * 16; e += NGW * 64) {
                const int t = e >> 4;
                norm_vec<128>(RA + (size_t)t * EVEN_INP + 256, kvlg, CQKV + (size_t)t * 384 + 256, lane & 15);
            }
            for (int e = gw * 64 + lane; e < T_ * 8; e += NGW * 64) {
                const int t = e >> 3;
                head_vec8<32>(RA + (size_t)t * EVEN_INP + 384, mkg + 64, true, true, 1.0f, CS32 + (size_t)t * 16, KROPE + (size_t)t * 32, lane & 7);
            }
            for (int e0 = gw * 64 + lane; e0 < T_ * 24 * 8; e0 += NGW * 64 * 4) {
                HVRaw hr[4]; bf16_t* dsts[4]; bool isk[4];
#pragma unroll
                for (int u4 = 0; u4 < 4; ++u4) {
                    const int ev = (e0 + u4 * NGW * 64) >> 3, t = ev / 24, gq = ev - t * 24, g = gq >> 3, qk = (gq >> 2) & 1, h = gq & 3, b = t >> 11, sq = t & 2047;
                    const int sh = (g == 0) ? 0 : (g == 1) ? 2 : 4;
                    const int pi = ((sq & ((1 << sh) - 1)) << (11 - sh)) + (sq >> sh);
                    dsts[u4] = (qk ? KD : QD) + ((size_t)((b * 3 + g) * 4 + h) * 2048 + pi) * 64; isk[u4] = qk != 0;
                    hv_load<64>(hr[u4], RA + (size_t)t * EVEN_INP + 416 + ((g * 3 + qk) * 4 + h) * 64, qk ? dkg : dqg, CS64 + (size_t)t * 32, lane & 7);
                }
#pragma unroll
                for (int u4 = 0; u4 < 4; ++u4) hv_finish<64>(hr[u4], true, true, isk[u4] ? 1.0f : 0.125f * LOG2E, dsts[u4], lane & 7);
            }
            for (int it = gw; it < 8 * 32 * 12; it += NGW) {
                const int gh = it % 12, ch = (it / 12) & 31, b = it / (12 * 32), g = gh >> 2, h = gh & 3;
                const bf16_t* src = RA + (size_t)(b * S_ + ch * 64) * EVEN_INP + 416 + ((g * 3 + 2) * 4 + h) * 64;
                bf16_t* dst = VTD + ((size_t)((b * 3 + g) * 4 + h) * 64 + lane) * 2048;
                if (g == 0) vt_item<1>(src, EVEN_INP, dst, ch * 64, 2048, lane);
                else if (g == 1) vt_item<4>(src, EVEN_INP, dst, ch * 64, 512, lane);
                else vt_item<16>(src, EVEN_INP, dst, ch * 64, 128, lane);
            }
            } }
            GSYNC();
            { KA_DEF pg8::EpiBf16S E{RA, 1792, nullptr}; run_gemm(TIDX, lds, CQKV, Wl + WO_BD, T_, 1792, 384, E); }
            GSYNC();
            { PH_VARS EWB_REP {
            const float* mqg = mla_q_g + j * 96; const float* mkg = mla_k_g + j * 96;
            const float SCQ = 0.10206207261596577f * LOG2E;
            for (int e0 = gw * 64 + lane; e0 < T_ * 16 * 8; e0 += NGW * 64 * 4) {
                HVRaw hr[4]; bf16_t* dsts[4]; bool isk[4];
#pragma unroll
                for (int u4 = 0; u4 < 4; ++u4) {
                    const int ev = (e0 + u4 * NGW * 64) >> 3, t = ev >> 4, which = (ev >> 3) & 1, h = ev & 7;
                    dsts[u4] = (which ? KM : QM) + ((size_t)t * 8 + h) * 96; isk[u4] = which != 0;
                    hv_load<64>(hr[u4], RA + (size_t)t * 1792 + (which ? 768 + h * 128 : h * 96), which ? mkg : mqg, CS64, lane & 7);
                }
#pragma unroll
                for (int u4 = 0; u4 < 4; ++u4) hv_finish<64>(hr[u4], true, false, isk[u4] ? 1.0f : SCQ, dsts[u4], lane & 7);
            }
            for (int e0 = gw * 64 + lane; e0 < T_ * 8 * 8; e0 += NGW * 64 * 2) {
                HVRaw hr[2]; u32x2 kr[2];
                const int sub = lane & 7;
#pragma unroll
                for (int u2 = 0; u2 < 2; ++u2) {
                    const int ev = (e0 + u2 * NGW * 64) >> 3, t = ev >> 3, h = ev & 7;
                    hv_load<32>(hr[u2], RA + (size_t)t * 1792 + h * 96 + 64, mqg + 64, CS32 + (size_t)t * 16, sub);
                    kr[u2] = *(const u32x2*)(KROPE + (size_t)t * 32 + sub * 4);
                }
#pragma unroll
                for (int u2 = 0; u2 < 2; ++u2) {
                    const int ev = (e0 + u2 * NGW * 64) >> 3, t = ev >> 3, h = ev & 7;
                    hv_finish<32>(hr[u2], true, true, SCQ, QM + ((size_t)t * 8 + h) * 96 + 64, sub);
                    *(u32x2*)(KM + ((size_t)t * 8 + h) * 96 + 64 + sub * 4) = kr[u2];
                }
            }
            for (int it = gw; it < 8 * 32 * 8; it += NGW) {
                const int h = it & 7, ch = (it >> 3) & 31, b = it >> 8;
                const bf16_t* src = RA + (size_t)(b * S_ + ch * 64) * 1792 + 768 + h * 128 + 64;
                bf16_t* dst = VTM + ((size_t)(b * 8 + h) * 64 + lane) * 2048;
                vt_item<1>(src, 1792, dst, ch * 64, 2048, lane);
            }
            } }
            GSYNC();
            { PH_VARS
            ATT_REP
            for (int ub = blockIdx.x; ub < 512; ub += GRID_BLOCKS) {
                const int pass = ub >> 8, idx = ub & 255, bh = idx & 63, i = idx >> 6, qb = pass ? i : 7 - i, b = bh >> 3, h = bh & 7;
                const int qt = qb * 8 + wave, q0 = qt * 32;
                f32x16 o[1][2]; float mm[1], ll[1];
                attn_block<96, 64, 0, false, 64, 1>(lds, QM + ((size_t)(b * S_ + q0) * 8 + h) * 96, 768, 0, KM + ((size_t)b * S_ * 8 + h) * 96, 768,
                                      VTM + (size_t)(b * 8 + h) * 64 * 2048, 2048, qb * 8 + 8, qt + 1, q0, nullptr, 0.f, o, mm, ll, tid);
                store_ot<64>(o[0], 1.0f / ll[0], MIX + (size_t)(b * S_ + q0 + r32) * 768 + h * 64, hi);
            }
            for (int u = gw; u < 6144; u += NGW) {
                f32x16 o[2]; float mm, ll;
                {
                    const int v = u, g = v >> 11, rest = v & 2047, qtile = rest & 63, b = (rest >> 6) & 7, h = rest >> 9;
                    const int sh = (g == 0) ? 0 : (g == 1) ? 2 : 4, Lg = 2048 >> sh, p0 = qtile * 32, rr = p0 / Lg, m0 = p0 % Lg;
                    const size_t base = (size_t)((b * 3 + g) * 4 + h);
                    const int ktl = (m0 >> 5) - 4 < 0 ? 0 : (m0 >> 5) - 4;
                    attn_tile<64, 64, 0, false, true>(QD + (base * 2048 + p0) * 64, 64, KD + (base * 2048 + (size_t)rr * Lg) * 64, 64,
                                                VTD + base * 64 * 2048 + (size_t)rr * Lg, 2048, ktl, (m0 >> 5) + 1, m0, 0, 128, nullptr, 0.f, o, mm, ll, lane);
                    const int s = ((m0 + r32) << sh) + rr; const size_t t = (size_t)b * S_ + s;
                    store_ot<64>(o, 1.0f / ll, ODIL + (t * 12 + g * 4 + h) * 64, hi);
                    if (hi == 0) LSE[t * 12 + g * 4 + h] = mm + log2f(ll);
                }
            }
            }
            GSYNC();
            { PH_VARS EWB_REP {
            for (int e = gw * 64 + lane; e < T_ * 32; e += NGW * 64) {
                const int t = e >> 5, h = (e >> 3) & 3, ch = e & 7;
                const float l0 = LSE[(size_t)t * 12 + h], l1 = LSE[(size_t)t * 12 + 4 + h], l2 = LSE[(size_t)t * 12 + 8 + h];
                const u32x4 a0 = *(const u32x4*)(ODIL + ((size_t)t * 12 + h) * 64 + ch * 8), a1 = *(const u32x4*)(ODIL + ((size_t)t * 12 + 4 + h) * 64 + ch * 8), a2 = *(const u32x4*)(ODIL + ((size_t)t * 12 + 8 + h) * 64 + ch * 8);
                const float mx = fmaxf(l0, fmaxf(l1, l2));
                float w0 = __builtin_amdgcn_exp2f(l0 - mx), w1 = __builtin_amdgcn_exp2f(l1 - mx), w2 = __builtin_amdgcn_exp2f(l2 - mx);
                const float inv = __builtin_amdgcn_rcpf(w0 + w1 + w2); w0 *= inv; w1 *= inv; w2 *= inv;
                u32x4 o;
#pragma unroll
                for (int q = 0; q < 4; ++q) {
                    const float lo = w0 * bf2f(a0[q] & 0xffffu) + w1 * bf2f(a1[q] & 0xffffu) + w2 * bf2f(a2[q] & 0xffffu);
                    const float hi2 = w0 * bf2f(a0[q] >> 16) + w1 * bf2f(a1[q] >> 16) + w2 * bf2f(a2[q] >> 16);
                    o[q] = pg8::cvt_pk_bf16(lo, hi2);
                }
                *(u32x4*)(MIX + (size_t)t * 768 + 512 + h * 64 + ch * 8) = o;
            }
            } }
            GSYNC();
            { KA_DEF pg8::EpiResid E{X, X, XB, SSQ, 1.0f}; run_gemm(TIDX, lds, MIX, Wl + WO_WOUT, T_, 1024, 768, E); }
            GSYNC();
        } else {
            { PH_VARS EWB_REP {
            const float* qg = sp_q_g + j * 64; const float* kg = sp_k_g + j * 64;
            for (int e0 = gw * 64 + lane; e0 < T_ * 26 * 8; e0 += NGW * 64 * 2) {
                HVRaw hr[2]; bf16_t* dsts[2]; int hhs[2];
#pragma unroll
                for (int u2 = 0; u2 < 2; ++u2) {
                    const int ev = (e0 + u2 * NGW * 64) >> 3, t = ev / 26, hh = ev - t * 26;
                    const int off = (hh < 16) ? hh * 64 : (hh == 16) ? 1024 : (hh < 25) ? 1152 + (hh - 17) * 64 : 1664;
                    dsts[u2] = (hh < 16) ? QSP + ((size_t)t * 16 + hh) * 64 : (hh == 16) ? KSP + (size_t)t * 64 : (hh < 25) ? QI + ((size_t)t * 8 + (hh - 17)) * 64 : KI + (size_t)t * 64;
                    hhs[u2] = hh;
                    hv_load<64>(hr[u2], RA + (size_t)t * ODD_INP + off, (hh == 16) ? kg : qg, CS64 + (size_t)t * 32, lane & 7);
                }
#pragma unroll
                for (int u2 = 0; u2 < 2; ++u2) hv_finish<64>(hr[u2], hhs[u2] <= 16, true, (hhs[u2] < 16) ? 0.125f * LOG2E : 1.0f, dsts[u2], lane & 7);
            }
            for (int e = gw * 64 + lane; e < T_ * 8; e += NGW * 64) {
                const int t = e >> 3, i = e & 7;
                WI[e] = bf2f(RA[(size_t)t * ODD_INP + 1728 + i]) * (0.35355339059327373f * 0.125f);
            }
            for (int it = gw; it < 8 * 32; it += NGW) {
                const int ch = it & 31, b = it >> 5;
                vt_item<1>(RA + (size_t)(b * S_ + ch * 64) * ODD_INP + 1088, ODD_INP, VTSP + ((size_t)b * 64 + lane) * 2048, ch * 64, 2048, lane);
            }
            } }
            GSYNC();
#ifndef SKIP_IDX
            { PH_VARS
            IDX_REP
            for (int ub = blockIdx.x; ub < 1024; ub += GRID_BLOCKS) {
                const int pass = ub >> 8, idx = ub & 255, b = idx & 7, i = idx >> 3;
                const int c16 = (pass == 0) ? 127 - i : (pass == 1) ? i : (pass == 2) ? 95 - i : 32 + i;
                const int t0 = c16 * 16 + wave * 2; const size_t tok0 = (size_t)b * S_ + t0;
                const int n = lane & 15, fq = lane >> 4, qs = fq >> 1, odd = fq & 1;
                bf16x8 qa[2];
#pragma unroll
                for (int kk = 0; kk < 2; ++kk) qa[kk] = *(const bf16x8*)(QI + ((tok0 + (n >> 3)) * 8 + (n & 7)) * 64 + kk * 32 + fq * 8);
                const f32x4 wv = *(const f32x4*)(WI + (tok0 + qs) * 8 + 4 * odd);
                const int tq = t0 + qs;
                constexpr int IKP = 144, ISTG = 256 * IKP;
                const int nstg = (c16 * 16 + 16 + 255) >> 8;
                const bf16_t* kib = KI + (size_t)b * S_ * 64;
                u32x4 stg[4];
#pragma unroll
                for (int q = 0; q < 4; ++q) stg[q] = *(const u32x4*)(kib + (size_t)(tid + q * 512) * 8);
#pragma unroll
                for (int q = 0; q < 4; ++q) { const int c = tid + q * 512; *(LAS u32x4*)(lds + (c >> 3) * IKP + (c & 7) * 16) = stg[q]; }
                __syncthreads();
                unsigned key[64];
#pragma unroll
                for (int sg = 0; sg < 8; ++sg) {
                    if (sg < nstg) {
                        const bool more = sg + 1 < nstg;
                        if (more) {
#pragma unroll
                            for (int q = 0; q < 4; ++q) stg[q] = *(const u32x4*)(kib + (size_t)(sg + 1) * 256 * 64 + (size_t)(tid + q * 512) * 8);
                        }
                        const LAS unsigned char* sb = lds + (sg & 1) * ISTG;
#pragma unroll
                        for (int j8 = 0; j8 < 8; ++j8) {
                            const int jj = sg * 8 + j8;
                            unsigned kv = 0u;
                            {
                                float sc2[2];
#pragma unroll
                                for (int tt = 0; tt < 2; ++tt) {
                                    const LAS unsigned char* kb = sb + ((2 * j8 + tt) * 16 + n) * IKP + fq * 16;
                                    f32x4 c4 = {0.f, 0.f, 0.f, 0.f};
                                    c4 = __builtin_amdgcn_mfma_f32_16x16x32_bf16(qa[0], *(const LAS bf16x8*)(kb), c4, 0, 0, 0);
                                    c4 = __builtin_amdgcn_mfma_f32_16x16x32_bf16(qa[1], *(const LAS bf16x8*)(kb + 64), c4, 0, 0, 0);
                                    float sc = wv[0] * fmaxf(c4[0], 0.f) + wv[1] * fmaxf(c4[1], 0.f) + wv[2] * fmaxf(c4[2], 0.f) + wv[3] * fmaxf(c4[3], 0.f);
                                    sc += __shfl_xor(sc, 16);
                                    sc2[tt] = sc;
                                }
                                float sc = odd ? sc2[1] : sc2[0];
                                if (sc == 0.f) sc = 0.f;
                                const unsigned ubits = __float_as_uint(sc);
                                kv = (ubits & 0x80000000u) ? ~ubits : (ubits | 0x80000000u);
                                if (32 * jj + 16 * odd + n > tq) kv = 0u;
                            }
                            key[jj] = kv;
                        }
                        if (more) {
                            LAS unsigned char* nb = lds + ((sg + 1) & 1) * ISTG;
#pragma unroll
                            for (int q = 0; q < 4; ++q) { const int c = tid + q * 512; *(LAS u32x4*)(nb + (c >> 3) * IKP + (c & 7) * 16) = stg[q]; }
                        }
                        __syncthreads();
                    } else {
#pragma unroll
                        for (int j8 = 0; j8 < 8; ++j8) key[sg * 8 + j8] = 0u;
                    }
                }
                LAS unsigned* wscr = (LAS unsigned*)(lds + 81920 + wave * 1024);
                unsigned tau = 0u;
                const bool all_valid = (tq + 1) <= 256;
                bool done_sel = all_valid;
#pragma unroll 1
                for (int bit = 31; bit >= 0; --bit) {
                    const unsigned cand = tau | (1u << bit);
                    int c0 = 0, c1 = 0;
#pragma unroll
                    for (int jj = 0; jj < 64; ++jj) { const unsigned long long bm = __ballot(key[jj] >= cand); c0 += __popc((unsigned)bm); c1 += __popc((unsigned)(bm >> 32)); }
                    const int cnt = (lane < 32) ? c0 : c1;
                    if (cnt >= 256) tau = cand;
                    done_sel = done_sel || (cnt == 256);
                    if (__ballot(!done_sel) == 0ull) break;
                }
                if (all_valid) tau = 1u;
                int g0 = 0, g1 = 0, e0 = 0, e1 = 0;
#pragma unroll
                for (int jj = 0; jj < 64; ++jj) {
                    const unsigned long long bg = __ballot(key[jj] > tau), be = __ballot(key[jj] == tau);
                    g0 += __popc((unsigned)bg); g1 += __popc((unsigned)(bg >> 32)); e0 += __popc((unsigned)be); e1 += __popc((unsigned)(be >> 32));
                }
                const int cgt = (lane < 32) ? g0 : g1, ceq = (lane < 32) ? e0 : e1;
                const int need_eq = all_valid ? (1 << 20) : 256 - cgt;
                const bool ties = (!all_valid) && (ceq > need_eq);
                unsigned w0 = 0u, w1 = 0u;
                if (__ballot(ties) == 0ull) {
#pragma unroll
                    for (int jj = 0; jj < 64; ++jj) {
                        const unsigned long long bm = __ballot(key[jj] >= tau);
                        if (lane == 0) { wscr[jj] = (unsigned)bm; wscr[64 + jj] = (unsigned)(bm >> 32); }
                    }
                } else {
                    int running = 0;
#pragma unroll
                    for (int jj = 0; jj < 64; ++jj) {
                        const bool e = key[jj] == tau;
                        const unsigned long long be = __ballot(e);
                        const unsigned hb = (unsigned)(be >> (32 * qs));
                        const int rank = running + __popc(hb & ((1u << (lane & 31)) - 1u));
                        running += __popc(hb);
                        const bool sel = (key[jj] > tau) || (e && rank < need_eq);
                        const unsigned long long bm = __ballot(sel);
                        if (lane == 0) { wscr[jj] = (unsigned)bm; wscr[64 + jj] = (unsigned)(bm >> 32); }
                    }
                }
                asm volatile("s_waitcnt lgkmcnt(0)" ::: "memory");
                w0 = wscr[lane]; w1 = wscr[64 + lane];
                MASKW[tok0 * 64 + lane] = w0; MASKW[(tok0 + 1) * 64 + lane] = w1;
                asm volatile("s_waitcnt lgkmcnt(0)" ::: "memory");
            }
            }
#endif
            GSYNC();
            { PH_VARS
            ATT_REP
            for (int ub = blockIdx.x; ub < 512; ub += GRID_BLOCKS) {
                const int pass = ub >> 8, idx = ub & 255, b = idx & 7, i = idx >> 3;
                const int qt = pass ? i : 63 - i, q0 = qt * 32, h = wave * 2;
                f32x16 o[2][2]; float mm[2], ll[2];
                attn_block<64, 64, 1, false, 64, 2>(lds, QSP + ((size_t)(b * S_ + q0) * 16 + h) * 64, 1024, 64, KSP + (size_t)b * S_ * 64, 64, VTSP + (size_t)b * 64 * 2048, 2048,
                                      qt + 1, qt + 1, q0, MASKW + (size_t)(b * S_ + q0) * 64, 0.f, o, mm, ll, tid);
                store_ot<64>(o[0], 1.0f / ll[0], MIX + (size_t)(b * S_ + q0 + r32) * 1024 + h * 64, hi);
                store_ot<64>(o[1], 1.0f / ll[1], MIX + (size_t)(b * S_ + q0 + r32) * 1024 + (h + 1) * 64, hi);
            }
            }
            GSYNC();
            { KA_DEF pg8::EpiResid E{X, X, XB, SSQ, 1.0f}; run_gemm(TIDX, lds, MIX, Wl + WO_WOUT, T_, 1024, 1024, E); }
            GSYNC();
        }
        { KA_DEF pg8::EpiBf16S E{RA, 1024, SSQ}; run_gemm(TIDX, lds, XB, Wl + WO_XQ, T_, 1024, 1024, E); }
        GSYNC();
        { PH_VARS
        ATT_REP
        for (int ub = blockIdx.x; ub < 512; ub += GRID_BLOCKS) {
            const int half = ub & 1, h = (ub >> 1) & 3, qblk = ub >> 3, b = qblk >> 3;
            const int tok0 = qblk * 256 + wave * 32;
            f32x16 o[1][4]; float mm[1], ll[1];
            const size_t kvb = (size_t)((l * 8 + b) * 4 + h) * 256;
            attn_block<256, 128, 2, true, 32, 1>(lds, RA + (size_t)tok0 * 1024 + h * 256, 1024, 0, KX + kvb * 256, 256, VTX + (kvb + half * 128) * 256, 256,
                                          8, 8, 0, nullptr, 0.0625f * LOG2E, o, mm, ll, tid);
            store_ot<128>(o[0], 1.0f / ll[0], OX + (size_t)(tok0 + r32) * 1024 + h * 256 + half * 128, hi);
        }
        }
        GSYNC();
        { KA_DEF pg8::EpiResid E{X, X, XB, SSQ, 1.0f}; run_gemm(TIDX, lds, OX, Wl + WO_XO, T_, 1024, 1024, E); }
        GSYNC();
        { KA_DEF pg8::EpiSwiGLU E{RA, FF, SSQ}; run_gemm(TIDX, lds, XB, Wl + WO_13B, T_, 2 * FF, 1024, E); }
        GSYNC();
        { KA_DEF pg8::EpiResid E{X, X, XB, SSQ, 0.5f}; run_gemm(TIDX, lds, RA, Wl + WO_2B, T_, 1024, FF, E); }
        if (l + 1 < NL) GSYNC();
    }
}

extern "C" void kernel_launch(void* const* d_in, const int* in_sizes, int n_in, void* d_out, int out_size, void* d_ws, size_t ws_size, hipStream_t stream) {
    static int grid = 0;
    if (grid == 0) {
        if (n_in != 31 || out_size != T_ * DM || ws_size < WS_END) { fprintf(stderr, "kernel_launch: unexpected shapes (n_in %d out %d ws %zu)\n", n_in, out_size, ws_size); grid = -1; return; }
        int dev = 0, cus = 0, per_cu = 0;
        hipGetDevice(&dev);
        hipDeviceGetAttribute(&cus, hipDeviceAttributeMultiprocessorCount, dev);
        if (hipFuncSetAttribute((const void*)mega_fwd, hipFuncAttributeMaxDynamicSharedMemorySize, LDS_BYTES) != hipSuccess) fprintf(stderr, "kernel_launch: hipFuncSetAttribute failed\n");
        if (hipOccupancyMaxActiveBlocksPerMultiprocessor(&per_cu, (const void*)mega_fwd, 512, LDS_BYTES) != hipSuccess || per_cu < 1) { fprintf(stderr, "kernel_launch: occupancy query says %d\n", per_cu); per_cu = 1; }
        (void)hipGetLastError();
        if (cus * per_cu < GRID_BLOCKS) fprintf(stderr, "kernel_launch: device holds %d co-resident workgroups, kernel is built for %d\n", cus * per_cu, GRID_BLOCKS);
        grid = GRID_BLOCKS;
    }
    if (grid < 0) return;
    if (hipMemsetAsync((char*)d_ws + WS_CTL, 0, 16384, stream) != hipSuccess) { fprintf(stderr, "kernel_launch: memset failed\n"); return; }
    KArgs a{};
    for (int i = 0; i < 31; ++i) a.in[i] = d_in[i];
    a.out = (float*)d_out; a.ws = (unsigned char*)d_ws;
    void* args[] = {&a};
    hipError_t e = hipLaunchCooperativeKernel((const void*)mega_fwd, dim3(grid), dim3(512), args, LDS_BYTES, stream);
    if (e != hipSuccess) fprintf(stderr, "kernel_launch: cooperative launch failed: %s (grid %d)\n", hipGetErrorString(e), grid);
}
```
